# Optimizing an MI355X kernel written in HIP

```python
import math
import jax, jax.numpy as jnp
from jax import lax
import numpy as np

D_MODEL = 1024
BATCH = 4
SEQ = 8192
DEPTH = 4

N_EVEN = (DEPTH + 1) // 2
N_ODD = DEPTH // 2
MIX_WIDTH = D_MODEL
A_WIDTH = MIX_WIDTH // 2
A_HEAD_DIM = 128
A_HEADS = A_WIDTH // A_HEAD_DIM
B_WIDTH = MIX_WIDTH - A_WIDTH
S5_GROUP = 16
S5_GROUPS = B_WIDTH // S5_GROUP
S5_STATE = 64
C_WIDTH = MIX_WIDTH // 2
C_HEAD_DIM = 64
C_HEADS = C_WIDTH // (2 * C_HEAD_DIM)
C_V_DIM = 2 * C_HEAD_DIM
D_WIDTH = MIX_WIDTH - C_WIDTH
D_HEAD_DIM = 128
D_HEADS = D_WIDTH // D_HEAD_DIM
CONV_WIDTH = 5
N_EXPERTS = 16
EXPERT_FF = 2 * D_MODEL
EC_CAPACITY_FACTOR = 2
REL_BUCKETS = 32
REL_MAX_DIST = 128
CHUNK = 64
Q_BLOCK = 128
EPS = 1e-6
EVEN_IN = 5 * A_WIDTH + B_WIDTH
ODD_IN = 3 * C_WIDTH + 3 * D_WIDTH + 4 * D_HEADS + D_WIDTH

kernel_name = 'hybrid_hgrn2_s5_diffattn_gdn_ecmoe_encoder'


def rmsnorm(x, g):
    xf = x.astype(jnp.float32)
    y = xf * lax.rsqrt(jnp.mean(xf * xf, axis=-1, keepdims=True) + EPS)
    return (y * g.astype(jnp.float32)).astype(x.dtype)


def l2norm(x):
    return x * lax.rsqrt(jnp.sum(x * x, axis=-1, keepdims=True) + EPS)


def _heads(t, n_heads):
    b, l, w = t.shape
    return jnp.transpose(t.reshape(b, l, n_heads, w // n_heads), (0, 2, 1, 3))


def _flip(t):
    return jnp.flip(t, axis=2)


def _to_chunks(t):
    b, h, l = t.shape[:3]
    t = t.reshape((b, h, l // CHUNK, CHUNK) + t.shape[3:])
    return jnp.moveaxis(t, 2, 0)


def _from_chunks(t):
    t = jnp.moveaxis(t, 0, 2)
    b, h, nc, c = t.shape[:4]
    return t.reshape((b, h, nc * c) + t.shape[4:])


def hgrn2_scan(q, k, v, log_f):
    tri = jnp.tril(jnp.ones((CHUNK, CHUNK), bool))[:, :, None]
    qc, kc, vc, lc = (_to_chunks(t) for t in (q, k, v, log_f))
    bc = jnp.cumsum(lc, axis=-2)

    def step(S, inp):
        q_, k_, v_, b_ = inp
        diff = b_[..., :, None, :] - b_[..., None, :, :]
        decay = jnp.where(tri, jnp.exp(jnp.where(tri, diff, 0.0)), 0.0)
        attn = jnp.einsum('bhtd,bhsd,bhtsd->bhts', q_, k_, decay)
        b_last = b_[..., -1, :]
        o = attn @ v_ + jnp.einsum('bhtd,bhdv->bhtv', q_ * jnp.exp(b_), S)
        S = jnp.exp(b_last)[..., None] * S + jnp.einsum(
            'bhsd,bhsv->bhdv', k_ * jnp.exp(b_last[..., None, :] - b_), v_)
        return S, o

    S0 = jnp.zeros(q.shape[:2] + (q.shape[-1], v.shape[-1]), jnp.float32)
    _, o = lax.scan(step, S0, (qc, kc, vc, bc))
    return _from_chunks(o)


def hgrn2_mixer(q_raw, f_fwd, f_bwd, i_raw, g_raw, lb, out_gain):
    f32 = jnp.float32
    b, l = q_raw.shape[:2]
    q = _heads(jax.nn.silu(q_raw.astype(f32)), A_HEADS)
    v = _heads(i_raw.astype(f32), A_HEADS)

    def gates(z, lbd):
        z = z.astype(f32)
        log_f = jnp.logaddexp(jnp.log(lbd), jnp.log1p(-lbd) + jax.nn.log_sigmoid(z))
        k = (1.0 - lbd) * jax.nn.sigmoid(-z)
        return _heads(log_f, A_HEADS), _heads(k, A_HEADS)

    lf_f, k_f = gates(f_fwd, lb[0])
    lf_b, k_b = gates(f_bwd, lb[1])
    o = hgrn2_scan(q, k_f, v, lf_f) + _flip(hgrn2_scan(_flip(q), _flip(k_b), _flip(v), _flip(lf_b)))
    o = rmsnorm(jnp.transpose(o, (0, 2, 1, 3)), out_gain).reshape(b, l, A_WIDTH)
    return o * jax.nn.silu(g_raw.astype(f32))


def s5_direction(u, lam_re, lam_im, log_step, b_re, b_im, c_re, c_im, reverse):
    step = jnp.exp(log_step)[:, None]
    mag = jnp.exp(lam_re * step)
    abar_re = mag * jnp.cos(lam_im * step)
    abar_im = mag * jnp.sin(lam_im * step)
    den = lam_re * lam_re + lam_im * lam_im
    fr = ((abar_re - 1.0) * lam_re + abar_im * lam_im) / den
    fi = (abar_im * lam_re - (abar_re - 1.0) * lam_im) / den
    bb_re = fr[..., None] * b_re - fi[..., None] * b_im
    bb_im = fr[..., None] * b_im + fi[..., None] * b_re
    bu_re = jnp.einsum('blgp,gnp->lbgn', u, bb_re)
    bu_im = jnp.einsum('blgp,gnp->lbgn', u, bb_im)
    l = u.shape[1]
    a_re = jnp.broadcast_to(abar_re, (l,) + abar_re.shape)
    a_im = jnp.broadcast_to(abar_im, (l,) + abar_im.shape)

    def combine(e1, e2):
        a1r, a1i, b1r, b1i = e1
        a2r, a2i, b2r, b2i = e2
        ar = a2r * a1r - a2i * a1i
        ai = a2r * a1i + a2i * a1r
        a2r_, a2i_ = a2r[:, None], a2i[:, None]
        br = a2r_ * b1r - a2i_ * b1i + b2r
        bi = a2r_ * b1i + a2i_ * b1r + b2i
        return ar, ai, br, bi

    _, _, xr, xi = lax.associative_scan(combine, (a_re, a_im, bu_re, bu_im), reverse=reverse, axis=0)
    return jnp.einsum('lbgn,gpn->blgp', xr, c_re) - jnp.einsum('lbgn,gpn->blgp', xi, c_im)


def s5_mixer(u_raw, lam_re, lam_im, log_step, b_re, b_im, c_re, c_im, d_skip, glu_w, glu_b):
    f32 = jnp.float32
    b, l = u_raw.shape[:2]
    u = u_raw.astype(f32).reshape(b, l, S5_GROUPS, S5_GROUP)
    y = d_skip.astype(f32).reshape(S5_GROUPS, S5_GROUP) * u
    for direction in range(2):
        y = y + s5_direction(u, lam_re[direction].astype(f32), lam_im[direction].astype(f32),
                             log_step[direction].astype(f32), b_re[direction].astype(f32),
                             b_im[direction].astype(f32), c_re[direction].astype(f32),
                             c_im[direction].astype(f32), reverse=(direction == 1))
    y = jax.nn.gelu(y.reshape(b, l, B_WIDTH))
    return y * jax.nn.sigmoid(y @ glu_w.astype(f32) + glu_b.astype(f32))


def t5_bucket(rel):
    half = REL_BUCKETS // 2
    max_exact = half // 2
    base = jnp.where(rel > 0, half, 0)
    n = jnp.abs(rel)
    nf = jnp.maximum(n, 1).astype(jnp.float32)
    large = max_exact + (jnp.log(nf / max_exact) / math.log(REL_MAX_DIST / max_exact)
                         * (half - max_exact)).astype(jnp.int32)
    large = jnp.minimum(large, half - 1)
    return base + jnp.where(n < max_exact, n, large)


def diff_attention(q_raw, k_raw, v_raw, q_gain, k_gain, lam, out_gain, rel_bias, layer_idx):
    f32 = jnp.float32
    b, l = q_raw.shape[:2]
    q = rmsnorm(q_raw.astype(f32).reshape(b, l, C_HEADS, 2, C_HEAD_DIM), q_gain) * (C_HEAD_DIM ** -0.5)
    k = rmsnorm(k_raw.astype(f32).reshape(b, l, C_HEADS, 2, C_HEAD_DIM), k_gain)
    v = v_raw.astype(f32).reshape(b, l, C_HEADS, C_V_DIM)
    lam_init = 0.8 - 0.6 * math.exp(-0.3 * layer_idx)
    lam_f = lam.astype(f32)
    lam_full = jnp.exp(jnp.sum(lam_f[0] * lam_f[1])) - jnp.exp(jnp.sum(lam_f[2] * lam_f[3])) + lam_init
    n_blocks = l // Q_BLOCK
    qb = jnp.moveaxis(q.reshape(b, n_blocks, Q_BLOCK, C_HEADS, 2, C_HEAD_DIM), 1, 0)
    k_pos = jnp.arange(l)
    table = rel_bias.astype(f32)

    def block(args):
        q_blk, blk = args
        q_pos = blk * Q_BLOCK + jnp.arange(Q_BLOCK)
        bias = jnp.transpose(table[t5_bucket(k_pos[None, :] - q_pos[:, None])], (2, 0, 1))
        s = jnp.einsum('bqhcd,bkhcd->bchqk', q_blk, k) + bias[None, None]
        p = jax.nn.softmax(s, axis=-1)
        w = p[:, 0] - lam_full * p[:, 1]
        return jnp.einsum('bhqk,bkhv->bqhv', w, v)

    o = lax.map(block, (qb, jnp.arange(n_blocks)))
    o = jnp.moveaxis(o, 0, 1).reshape(b, l, C_HEADS, C_V_DIM)
    o = rmsnorm(o, out_gain) * (1.0 - lam_init)
    return o.reshape(b, l, C_WIDTH)


def short_conv(x, w):
    ch = x.shape[-1]
    pad = CONV_WIDTH // 2
    return lax.conv_general_dilated(x, w[:, None, :].astype(x.dtype), window_strides=(1,),
                                    padding=[(pad, pad)], dimension_numbers=('NWC', 'WIO', 'NWC'),
                                    feature_group_count=ch)


def gdn_scan(q, k, v, g, beta):
    b, h, l, dk = q.shape
    dv = v.shape[-1]
    nc = l // CHUNK

    def chunks(t):
        return t.reshape((b, h, nc, CHUNK) + t.shape[3:])

    q, k, v, g, beta = (chunks(t) for t in (q, k, v, g, beta))
    gam = jnp.cumsum(g, axis=-1)
    incl = jnp.tril(jnp.ones((CHUNK, CHUNK), bool))
    strict = jnp.tril(jnp.ones((CHUNK, CHUNK), bool), -1)
    diff = gam[..., :, None] - gam[..., None, :]
    decay = jnp.where(incl, jnp.exp(jnp.where(incl, diff, 0.0)), 0.0)
    k_beta = k * beta[..., None]
    v_beta = v * beta[..., None]
    a = jnp.where(strict, jnp.einsum('bhntd,bhnsd->bhnts', k_beta, k) * decay, 0.0)
    m = a + jnp.eye(CHUNK, dtype=a.dtype)
    value = lax.linalg.triangular_solve(m, v_beta, left_side=True, lower=True, unit_diagonal=True)
    k_cum = lax.linalg.triangular_solve(m, k_beta * jnp.exp(gam)[..., None], left_side=True,
                                        lower=True, unit_diagonal=True)
    attn = jnp.einsum('bhntd,bhnsd->bhnts', q, k) * decay
    q_dec = q * jnp.exp(gam)[..., None]
    g_last = gam[..., -1]
    k_dec = k * jnp.exp(g_last[..., None] - gam)[..., None]
    xs = tuple(jnp.moveaxis(t, 2, 0) for t in (value, k_cum, attn, q_dec, k_dec, g_last))

    def step(S, inp):
        val, kc, at, qd, kd, gl = inp
        v_new = val - kc @ S
        o = qd @ S + at @ v_new
        S = jnp.exp(gl)[..., None, None] * S + jnp.einsum('bhsd,bhsv->bhdv', kd, v_new)
        return S, o

    S0 = jnp.zeros((b, h, dk, dv), jnp.float32)
    _, o = lax.scan(step, S0, xs)
    return jnp.moveaxis(o, 0, 2).reshape(b, h, l, dv)


def gated_deltanet(qkv_raw, a_raw, b_raw, g_raw, conv_w, a_log, dt_bias, out_gain):
    f32 = jnp.float32
    bsz, l = qkv_raw.shape[:2]
    qkv = jax.nn.silu(short_conv(qkv_raw, conv_w).astype(f32))
    q, k, v = jnp.split(qkv, 3, axis=-1)
    q = l2norm(_heads(q, D_HEADS)) * (D_HEAD_DIM ** -0.5)
    k = l2norm(_heads(k, D_HEADS))
    v = _heads(v, D_HEADS)
    a = a_raw.astype(f32).reshape(bsz, l, 2, D_HEADS)
    bb = b_raw.astype(f32).reshape(bsz, l, 2, D_HEADS)
    a_log = a_log.astype(f32)
    dt_bias = dt_bias.astype(f32)
    o = jnp.zeros((bsz, D_HEADS, l, D_HEAD_DIM), f32)
    for direction in range(2):
        g = -jnp.exp(a_log[direction]) * jax.nn.softplus(a[:, :, direction] + dt_bias[direction])
        beta = jax.nn.sigmoid(bb[:, :, direction])
        g = jnp.transpose(g, (0, 2, 1))
        beta = jnp.transpose(beta, (0, 2, 1))
        if direction == 0:
            o = o + gdn_scan(q, k, v, g, beta)
        else:
            o = o + _flip(gdn_scan(_flip(q), _flip(k), _flip(v), _flip(g), _flip(beta)))
    o = rmsnorm(jnp.transpose(o, (0, 2, 1, 3)), out_gain).reshape(bsz, l, D_WIDTH)
    return o * jax.nn.silu(g_raw.astype(f32))


def ec_moe(h, w_router, w_gate, w_up, w_down):
    b, l, d = h.shape
    cap = EC_CAPACITY_FACTOR * l // N_EXPERTS
    logits = jnp.einsum('bld,de->ble', h, w_router).astype(jnp.float32)
    aff = jax.nn.softmax(logits, axis=-1)
    gate, idx = lax.top_k(jnp.swapaxes(aff, 1, 2), cap)
    xs = jax.vmap(lambda hb, ib: hb[ib])(h, idx)
    hid = jax.nn.silu(jnp.einsum('becd,edf->becf', xs, w_gate)) * jnp.einsum('becd,edf->becf', xs, w_up)
    out = jnp.einsum('becf,efd->becd', hid, w_down) * gate[..., None].astype(h.dtype)
    return jax.vmap(lambda ob, ib: jnp.zeros((l, d), ob.dtype).at[ib.reshape(-1)].add(ob.reshape(-1, d)))(out, idx)


def setup_inputs(seed: int = 0) -> dict:
    key = jax.random.key(seed)
    ks = jax.random.split(key, 32)
    nrm = jax.random.normal
    f32 = jnp.float32
    x = nrm(ks[0], (BATCH, SEQ, D_MODEL), f32)
    mix_norm = 1.0 + 0.02 * nrm(ks[1], (DEPTH, D_MODEL), f32)
    ffn_norm = 1.0 + 0.02 * nrm(ks[2], (DEPTH, D_MODEL), f32)
    ev_w_in = nrm(ks[3], (N_EVEN, D_MODEL, EVEN_IN), f32) * D_MODEL ** -0.5
    ev_w_out = nrm(ks[4], (N_EVEN, MIX_WIDTH, D_MODEL), f32) * MIX_WIDTH ** -0.5
    a_lb_logits = 0.1 * nrm(ks[5], (N_EVEN, 2, A_WIDTH), f32)
    a_out_norm = 1.0 + 0.02 * nrm(ks[6], (N_EVEN, A_HEAD_DIM), f32)
    s5_shape = (N_EVEN, 2, S5_GROUPS, S5_STATE)
    s5_lambda_re = -0.5 + 0.01 * nrm(ks[7], s5_shape, f32)
    s5_lambda_im = math.pi * jnp.arange(S5_STATE, dtype=f32) + 0.01 * nrm(ks[8], s5_shape, f32)
    s5_log_step = jax.random.uniform(ks[9], (N_EVEN, 2, S5_GROUPS), f32, math.log(1e-3), math.log(1e-1))
    s5_b_re = nrm(ks[10], s5_shape + (S5_GROUP,), f32) * (2 * S5_GROUP) ** -0.5
    s5_b_im = nrm(ks[11], s5_shape + (S5_GROUP,), f32) * (2 * S5_GROUP) ** -0.5
    c_shape = (N_EVEN, 2, S5_GROUPS, S5_GROUP, S5_STATE)
    s5_c_re = nrm(ks[12], c_shape, f32) * S5_STATE ** -0.5
    s5_c_im = nrm(ks[13], c_shape, f32) * S5_STATE ** -0.5
    s5_d = 0.5 * nrm(ks[14], (N_EVEN, B_WIDTH), f32)
    s5_glu_w = nrm(ks[15], (N_EVEN, B_WIDTH, B_WIDTH), f32) * B_WIDTH ** -0.5
    s5_glu_b = 0.01 * nrm(ks[16], (N_EVEN, B_WIDTH), f32)
    od_w_in = nrm(ks[17], (N_ODD, D_MODEL, ODD_IN), f32) * D_MODEL ** -0.5
    od_w_out = nrm(ks[18], (N_ODD, MIX_WIDTH, D_MODEL), f32) * MIX_WIDTH ** -0.5
    c_q_norm = 1.0 + 0.02 * nrm(ks[19], (N_ODD, C_HEAD_DIM), f32)
    c_k_norm = 1.0 + 0.02 * nrm(ks[20], (N_ODD, C_HEAD_DIM), f32)
    c_lambda = 0.1 * nrm(ks[21], (N_ODD, 4, C_HEAD_DIM), f32)
    c_out_norm = 1.0 + 0.02 * nrm(ks[22], (N_ODD, C_V_DIM), f32)
    rel_bias = 0.5 * nrm(ks[23], (REL_BUCKETS, C_HEADS), f32)
    d_conv_w = nrm(ks[24], (N_ODD, CONV_WIDTH, 3 * D_WIDTH), f32) * CONV_WIDTH ** -0.5
    d_a_log = jnp.log(jax.random.uniform(ks[25], (N_ODD, 2, D_HEADS), f32, 1.0, 16.0))
    dt = jnp.exp(jax.random.uniform(ks[26], (N_ODD, 2, D_HEADS), f32, math.log(1e-3), math.log(1e-1)))
    d_dt_bias = dt + jnp.log(-jnp.expm1(-dt))
    d_out_norm = 1.0 + 0.02 * nrm(ks[27], (N_ODD, D_HEAD_DIM), f32)
    moe_router = nrm(ks[28], (DEPTH, D_MODEL, N_EXPERTS), f32) * D_MODEL ** -0.5
    moe_w_gate = nrm(ks[29], (DEPTH, N_EXPERTS, D_MODEL, EXPERT_FF), f32) * D_MODEL ** -0.5
    moe_w_up = nrm(ks[30], (DEPTH, N_EXPERTS, D_MODEL, EXPERT_FF), f32) * D_MODEL ** -0.5
    moe_w_down = nrm(ks[31], (DEPTH, N_EXPERTS, EXPERT_FF, D_MODEL), f32) * EXPERT_FF ** -0.5
    return {'x': x, 'mix_norm': mix_norm, 'ffn_norm': ffn_norm, 'ev_w_in': ev_w_in, 'ev_w_out': ev_w_out,
            'a_lb_logits': a_lb_logits, 'a_out_norm': a_out_norm, 's5_lambda_re': s5_lambda_re,
            's5_lambda_im': s5_lambda_im, 's5_log_step': s5_log_step, 's5_b_re': s5_b_re, 's5_b_im': s5_b_im,
            's5_c_re': s5_c_re, 's5_c_im': s5_c_im, 's5_d': s5_d, 's5_glu_w': s5_glu_w, 's5_glu_b': s5_glu_b,
            'od_w_in': od_w_in, 'od_w_out': od_w_out, 'c_q_norm': c_q_norm, 'c_k_norm': c_k_norm,
            'c_lambda': c_lambda, 'c_out_norm': c_out_norm, 'rel_bias': rel_bias, 'd_conv_w': d_conv_w,
            'd_a_log': d_a_log, 'd_dt_bias': d_dt_bias, 'd_out_norm': d_out_norm, 'moe_router': moe_router,
            'moe_w_gate': moe_w_gate, 'moe_w_up': moe_w_up, 'moe_w_down': moe_w_down}


def reference(x, mix_norm, ffn_norm, ev_w_in, ev_w_out, a_lb_logits, a_out_norm, s5_lambda_re,
              s5_lambda_im, s5_log_step, s5_b_re, s5_b_im, s5_c_re, s5_c_im, s5_d, s5_glu_w, s5_glu_b,
              od_w_in, od_w_out, c_q_norm, c_k_norm, c_lambda, c_out_norm, rel_bias, d_conv_w,
              d_a_log, d_dt_bias, d_out_norm, moe_router, moe_w_gate, moe_w_up, moe_w_down):
    p = jax.nn.softmax(a_lb_logits.astype(jnp.float32), axis=0)
    cum = jnp.cumsum(p, axis=0)
    lower_bounds = cum - cum[0:1]
    for layer in range(DEPTH):
        h = rmsnorm(x, mix_norm[layer])
        j = layer // 2
        if layer % 2 == 0:
            proj = h @ ev_w_in[j]
            q_a, f_fw, f_bw, i_a, g_a, u_b = jnp.split(
                proj, [A_WIDTH, 2 * A_WIDTH, 3 * A_WIDTH, 4 * A_WIDTH, 5 * A_WIDTH], axis=-1)
            o_a = hgrn2_mixer(q_a, f_fw, f_bw, i_a, g_a, lower_bounds[j], a_out_norm[j])
            o_b = s5_mixer(u_b, s5_lambda_re[j], s5_lambda_im[j], s5_log_step[j], s5_b_re[j], s5_b_im[j],
                           s5_c_re[j], s5_c_im[j], s5_d[j], s5_glu_w[j], s5_glu_b[j])
            mixed = jnp.concatenate([o_a, o_b], axis=-1).astype(x.dtype)
            x = x + mixed @ ev_w_out[j]
        else:
            o1 = 3 * C_WIDTH
            o2 = o1 + 3 * D_WIDTH
            o3 = o2 + 2 * D_HEADS
            o4 = o3 + 2 * D_HEADS
            q_c, k_c, v_c, qkv_d, a_d, b_d, g_d = jnp.split(
                h @ od_w_in[j], [C_WIDTH, 2 * C_WIDTH, o1, o2, o3, o4], axis=-1)
            o_c = diff_attention(q_c, k_c, v_c, c_q_norm[j], c_k_norm[j], c_lambda[j], c_out_norm[j],
                                 rel_bias, layer)
            o_d = gated_deltanet(qkv_d, a_d, b_d, g_d, d_conv_w[j], d_a_log[j], d_dt_bias[j], d_out_norm[j])
            mixed = jnp.concatenate([o_c, o_d], axis=-1).astype(x.dtype)
            x = x + mixed @ od_w_out[j]
        x = x + ec_moe(rmsnorm(x, ffn_norm[layer]), moe_router[layer], moe_w_gate[layer],
                       moe_w_up[layer], moe_w_down[layer])
    return x
```

```cpp
#include <hip/hip_runtime.h>
#include <cstdio>
#include <cstdint>

#define GAS __attribute__((address_space(1)))
#define LAS __attribute__((address_space(3)))
typedef unsigned short bf16;
typedef unsigned short bf16_t;
typedef short bf16x8 __attribute__((ext_vector_type(8)));
typedef short bf16x4 __attribute__((ext_vector_type(4)));
typedef float f32x4 __attribute__((ext_vector_type(4)));
typedef float f32x2 __attribute__((ext_vector_type(2)));
typedef float f32x16 __attribute__((ext_vector_type(16)));
typedef unsigned u32x4 __attribute__((ext_vector_type(4)));
typedef unsigned u32x2 __attribute__((ext_vector_type(2)));

constexpr int NB = 4, SEQ = 8192, DM = 1024, T = NB * SEQ, NCH = SEQ / 64;
constexpr int EVEN_IN = 3072, ODD_IN = 3600, ODD_N = 3584;
constexpr int NE = 16, FF = 2048, CAP = 1024, NSLOT = NE * NB * CAP;
constexpr float EPS = 1e-6f;
constexpr float LOG2E = 1.4426950408889634f;

typedef float f32x2_t __attribute__((ext_vector_type(2))); typedef __bf16 bf16x2_t __attribute__((ext_vector_type(2)));
__device__ __forceinline__ unsigned cvt_pk_bf16(float lo, float hi) { f32x2_t v = {lo, hi}; bf16x2_t b = __builtin_convertvector(v, bf16x2_t); return __builtin_bit_cast(unsigned, b); }
__device__ __forceinline__ float bf2f(unsigned short b) { return __uint_as_float(((unsigned)b) << 16); }
__device__ __forceinline__ float bflo(unsigned w) { return __uint_as_float(w << 16); }
__device__ __forceinline__ float bfhi(unsigned w) { return __uint_as_float(w & 0xffff0000u); }
__device__ __forceinline__ unsigned short f2bf(float f) { return (unsigned short)(cvt_pk_bf16(f, 0.f) & 0xffffu); }
__device__ __forceinline__ float wave_sum(float v) {
    v += __int_as_float(__builtin_amdgcn_update_dpp(0, __float_as_int(v), 0xB1, 0xf, 0xf, true));
    v += __int_as_float(__builtin_amdgcn_update_dpp(0, __float_as_int(v), 0x4E, 0xf, 0xf, true));
    v += __int_as_float(__builtin_amdgcn_update_dpp(0, __float_as_int(v), 0x141, 0xf, 0xf, true));
    v += __int_as_float(__builtin_amdgcn_update_dpp(0, __float_as_int(v), 0x140, 0xf, 0xf, true));
    const int vi = __float_as_int(v);
    const float r0 = __int_as_float(__builtin_amdgcn_readlane(vi, 0)), r1 = __int_as_float(__builtin_amdgcn_readlane(vi, 16)), r2 = __int_as_float(__builtin_amdgcn_readlane(vi, 32)), r3 = __int_as_float(__builtin_amdgcn_readlane(vi, 48));
    return (r0 + r1) + (r2 + r3);
}
__device__ __forceinline__ float half_sum(float v, int lane) {
    v += __int_as_float(__builtin_amdgcn_update_dpp(0, __float_as_int(v), 0xB1, 0xf, 0xf, true));
    v += __int_as_float(__builtin_amdgcn_update_dpp(0, __float_as_int(v), 0x4E, 0xf, 0xf, true));
    v += __int_as_float(__builtin_amdgcn_update_dpp(0, __float_as_int(v), 0x141, 0xf, 0xf, true));
    v += __int_as_float(__builtin_amdgcn_update_dpp(0, __float_as_int(v), 0x140, 0xf, 0xf, true));
    const int vi = __float_as_int(v);
    const float r0 = __int_as_float(__builtin_amdgcn_readlane(vi, 0)), r1 = __int_as_float(__builtin_amdgcn_readlane(vi, 16)), r2 = __int_as_float(__builtin_amdgcn_readlane(vi, 32)), r3 = __int_as_float(__builtin_amdgcn_readlane(vi, 48));
    return lane < 32 ? r0 + r1 : r2 + r3;
}
__device__ __forceinline__ float shfl_xor32(float v, int lane) { return __int_as_float(__builtin_amdgcn_ds_bpermute((lane ^ 32) << 2, __float_as_int(v))); }
__device__ __forceinline__ float shfl_up_f(float v, int o, int lane) { return __int_as_float(__builtin_amdgcn_ds_bpermute((lane >= o ? lane - o : lane) << 2, __float_as_int(v))); }
__device__ __forceinline__ unsigned shfl_up_u(unsigned v, int o, int lane) { return (unsigned)__builtin_amdgcn_ds_bpermute((lane >= o ? lane - o : lane) << 2, (int)v); }
#if defined(FP8EMU) || defined(EMU2) || defined(EMU3)
__device__ __forceinline__ float q8(float x, float sc) { const int p = __builtin_amdgcn_cvt_pk_fp8_f32(x * sc, 0.f, 0, false); return __builtin_amdgcn_cvt_f32_fp8(p, 0) * (1.f / sc); }
#else
__device__ __forceinline__ float q8(float x, float) { return x; }
#endif
__device__ __forceinline__ unsigned pk_fp8x4(float a, float b, float c, float d) { int p = __builtin_amdgcn_cvt_pk_fp8_f32(a, b, 0, false); p = __builtin_amdgcn_cvt_pk_fp8_f32(c, d, p, true); return (unsigned)p; }
#ifdef EMU3
#define Q3(x, s) q8((x), (s))
#else
#define Q3(x, s) (x)
#endif
#if defined(EMU2) && (EMU2 & 1)
#define QM(x) q8((x), 16.f)
#else
#define QM(x) (x)
#endif
__device__ __forceinline__ float fast_exp(float x) { return __builtin_amdgcn_exp2f(x * LOG2E); }
__device__ __forceinline__ float fast_log(float x) { return __builtin_amdgcn_logf(x) * 0.6931471805599453f; }
__device__ __forceinline__ float fast_rcp(float x) { return __builtin_amdgcn_rcpf(x); }
__device__ __forceinline__ float sigmoidf_(float x) { return fast_rcp(1.f + fast_exp(-x)); }
__device__ __forceinline__ float siluf_(float x) { return x * sigmoidf_(x); }
__device__ __forceinline__ float gelu_tanh(float x) { const float u = 1.5957691216057308f * (x + 0.044715f * x * x * x); return x * fast_rcp(1.f + fast_exp(-u)); }
__device__ __forceinline__ void lds_barrier() { asm volatile("s_waitcnt lgkmcnt(0)" ::: "memory"); __builtin_amdgcn_s_barrier(); asm volatile("" ::: "memory"); }
#define LDS_WAIT() asm volatile("s_waitcnt lgkmcnt(0)" ::: "memory")
#define VM_WAIT() asm volatile("s_waitcnt vmcnt(0)" ::: "memory")

struct EpiBf16; struct EpiBf16S;
namespace pg8 {
#define PG8_LAS __attribute__((address_space(3)))
constexpr int BM = 256, BK = 64, HALF = 128, HTB = HALF * BK * 2, STAGE_BYTES = 8 * HTB, NXCD = 8, WGM = 8;
__host__ __device__ __forceinline__ int lds_byte(int r, int c) { const int st = (r >> 4) * 2 + (c >> 5), rr = r & 15, cc = c & 31, ob = rr * 64 + cc * 2; return st * 1024 + (ob ^ (((ob >> 9) & 1) << 5)); }
__host__ __device__ __forceinline__ void stage_rc(int b, int& R, int& C) { const int st = b / 1024, sb = b % 1024, swz = sb ^ (((sb >> 9) & 1) << 5); R = (st >> 1) * 16 + swz / 64; C = (st & 1) * 32 + (swz % 64) / 2; }
__host__ __device__ __forceinline__ int perm32(int rho) { const int n = rho >> 4, i = rho & 15; return 8 * (i >> 2) + 4 * n + (i & 3); }

struct Unit { int pm, pn, pb; };
struct Gemm { const bf16_t* A; const bf16_t* Bt; int K, lda, ldb; };

struct Sched {
    int nM, nN, nwg, G, c, gdiv, gmul;
    __device__ __forceinline__ void init(int nM_, int nN_, int G_, int c_, int gdiv_, int gmul_) { nM = nM_; nN = nN_; nwg = nM * nN; G = G_; c = c_; gdiv = gdiv_; gmul = gmul_; }
    __device__ __forceinline__ bool next(int i, Unit& u) const {
        const int L = i * G + c; if (L >= nwg) return false;
        int wgid = L; { const int q = nwg / NXCD, r = nwg % NXCD, xcd = wgid % NXCD, off = wgid / NXCD; wgid = (xcd < r ? xcd * (q + 1) : r * (q + 1) + (xcd - r) * q) + off; }
        const int nig = WGM * nN, gid = wgid / nig, fm = gid * WGM, gsz = (nM - fm) < WGM ? (nM - fm) : WGM;
        u.pm = fm + ((wgid % nig) % gsz); u.pn = (wgid % nig) / gsz; u.pb = (u.pm >> gdiv) * gmul + u.pn; return true;
    }
};

template <class Epi>
__device__ __forceinline__ void gemm_phase(PG8_LAS unsigned char* lds, const Gemm g, const Sched& S, const Epi& E, const int tid) {
    const int wid = __builtin_amdgcn_readfirstlane(tid >> 6), lane = tid & 63, wr = wid >> 2, wc = wid & 3, fr = lane & 15, fq = lane >> 4;
    const int K = g.K, nt = K / BK;
    unsigned voffA[2], voffB[2];
#pragma unroll
    for (int i = 0; i < 2; ++i) { int R, C; stage_rc(tid * 16 + i * 8192, R, C); const int Rb = ((R & ~31) + perm32(R & 31));
        voffA[i] = (unsigned)(R * g.lda + C) * 2u; voffB[i] = (unsigned)(Rb * g.ldb + C) * 2u; }
    const size_t kstep = (size_t)(BK * 2);
    const size_t hstepA = (size_t)HALF * g.lda * 2, hstepB = (size_t)HALF * g.ldb * 2;
    const size_t tstepA = 2 * hstepA, tstepB = 2 * hstepB;
    const unsigned ldsw = (unsigned)wid * 1024u;
    const int aoff = lds_byte(wr * 64 + fr, fq * 8), boff = lds_byte(wc * 32 + fr, fq * 8);
#define PG8_SA(b, h) (((b) * 2 + (h)) * HTB)
#define PG8_SB(b, h) ((4 + (b) * 2 + (h)) * HTB)
#define PG8_STAGE(bufoff, gbase, voff) do { _Pragma("unroll") for (int _i = 0; _i < 2; ++_i) \
        __builtin_amdgcn_global_load_lds((const unsigned*)((const char*)(gbase) + (voff)[_i]), (PG8_LAS unsigned*)(lds + (bufoff) + ldsw + _i * 8192), 16, 0, 0); } while (0)
#define PG8_LDA(dst, b, h) do { _Pragma("unroll") for (int m = 0; m < 4; ++m) _Pragma("unroll") for (int k = 0; k < 2; ++k) dst[m][k] = *(const PG8_LAS bf16x8*)(lds + PG8_SA(b, h) + aoff + m * 2048 + k * 1024); } while (0)
#define PG8_LDB(dst, b, h) do { _Pragma("unroll") for (int n = 0; n < 2; ++n) _Pragma("unroll") for (int k = 0; k < 2; ++k) dst[n][k] = *(const PG8_LAS bf16x8*)(lds + PG8_SB(b, h) + boff + n * 2048 + k * 1024); } while (0)
#define PG8_MMA(ai, bj, At, Bt) do { __builtin_amdgcn_s_setprio(1); _Pragma("unroll") for (int m = 0; m < 4; ++m) _Pragma("unroll") for (int n = 0; n < 2; ++n) _Pragma("unroll") for (int k = 0; k < 2; ++k) \
        acc[ai][bj][m][n] = __builtin_amdgcn_mfma_f32_16x16x32_bf16(Bt[n][k], At[m][k], acc[ai][bj][m][n], 0, 0, 0); __builtin_amdgcn_s_setprio(0); } while (0)
#define PG8_WAIT_V(n) asm volatile("s_waitcnt vmcnt(" #n ")" ::: "memory")
#define PG8_WAIT_L(n) asm volatile("s_waitcnt lgkmcnt(" #n ")" ::: "memory")
#define PG8_BAR __builtin_amdgcn_s_barrier()
#define PG8_SCHED __builtin_amdgcn_sched_barrier(0)
    Unit cur, nxt; int ui = 0;
    if (!S.next(0, cur)) return;
    f32x4 acc[2][2][4][2];
#pragma unroll
    for (int a = 0; a < 2; ++a)
#pragma unroll
        for (int b = 0; b < 2; ++b)
#pragma unroll
            for (int m = 0; m < 4; ++m)
#pragma unroll
                for (int n = 0; n < 2; ++n) acc[a][b][m][n] = (f32x4){0.f, 0.f, 0.f, 0.f};
    bf16x8 At[4][2], B0[2][2], B1[2][2];
    const char* cA = (const char*)g.A + (size_t)cur.pm * tstepA; const char* cB = (const char*)g.Bt + (size_t)cur.pb * tstepB;
    PG8_STAGE(PG8_SB(0, 0), cB, voffB); PG8_STAGE(PG8_SB(0, 1), cB + hstepB, voffB); PG8_STAGE(PG8_SA(0, 0), cA, voffA); PG8_STAGE(PG8_SA(0, 1), cA + hstepA, voffA);
    if (wr == 1) PG8_BAR;
    PG8_WAIT_V(2); PG8_BAR;
    PG8_STAGE(PG8_SB(1, 0), cB + kstep, voffB); PG8_STAGE(PG8_SA(1, 0), cA + kstep, voffA); PG8_STAGE(PG8_SB(1, 1), cB + hstepB + kstep, voffB);
    PG8_WAIT_V(6); PG8_BAR;
    for (;;) {
        const bool has_next = S.next(ui + 1, nxt);
        const char* nA = has_next ? (const char*)g.A + (size_t)nxt.pm * tstepA : cA; const char* nB = has_next ? (const char*)g.Bt + (size_t)nxt.pb * tstepB : cB;
#pragma nounroll
        for (int t = 0; t < nt; t += 2) {
            const bool last = (t == nt - 2);
            const char* a1 = cA + (size_t)(t + 1) * kstep;
            const char* a2 = last ? nA : cA + (size_t)(t + 2) * kstep; const char* b2 = last ? nB : cB + (size_t)(t + 2) * kstep;
            const char* a3 = a2 + kstep; const char* b3 = b2 + kstep;
            PG8_LDB(B0, 0, 0); PG8_LDB(B1, 0, 1); PG8_SCHED; PG8_LDA(At, 0, 0); PG8_STAGE(PG8_SA(1, 1), a1 + hstepA, voffA);
            PG8_WAIT_V(8); PG8_WAIT_L(0); PG8_BAR; PG8_MMA(0, 0, At, B0); PG8_MMA(0, 1, At, B1); PG8_BAR; PG8_SCHED;
            PG8_LDA(At, 0, 1); PG8_STAGE(PG8_SB(0, 0), b2, voffB); PG8_STAGE(PG8_SB(0, 1), b2 + hstepB, voffB); PG8_STAGE(PG8_SA(0, 0), a2, voffA);
            PG8_WAIT_V(8); PG8_WAIT_L(0); PG8_BAR; PG8_MMA(1, 0, At, B0); PG8_MMA(1, 1, At, B1); PG8_BAR; PG8_SCHED;
            PG8_LDB(B0, 1, 0); PG8_LDB(B1, 1, 1); PG8_SCHED; PG8_LDA(At, 1, 0); PG8_STAGE(PG8_SA(0, 1), a2 + hstepA, voffA);
            PG8_WAIT_V(8); PG8_WAIT_L(0); PG8_BAR; PG8_MMA(0, 0, At, B0); PG8_MMA(0, 1, At, B1); PG8_BAR; PG8_SCHED;
            PG8_LDA(At, 1, 1); PG8_STAGE(PG8_SB(1, 0), b3, voffB); PG8_STAGE(PG8_SB(1, 1), b3 + hstepB, voffB); PG8_STAGE(PG8_SA(1, 0), a3, voffA);
            PG8_WAIT_V(8); PG8_WAIT_L(0); PG8_BAR; PG8_MMA(1, 0, At, B0); PG8_MMA(1, 1, At, B1); PG8_BAR; PG8_SCHED;
        }
        if (wr == 0) PG8_BAR;
        E(acc, cur, wr, wc, fr, fq);
#ifdef EPI_DUP
        if (__is_same(Epi, ::EpiBf16) || __is_same(Epi, ::EpiBf16S)) { asm volatile("" ::: "memory"); E(acc, cur, wr, wc, fr, fq); }
#endif
        if (!has_next) break;
#pragma unroll
        for (int a = 0; a < 2; ++a)
#pragma unroll
            for (int b = 0; b < 2; ++b)
#pragma unroll
                for (int m = 0; m < 4; ++m)
#pragma unroll
                    for (int n = 0; n < 2; ++n) acc[a][b][m][n] = (f32x4){0.f, 0.f, 0.f, 0.f};
        cur = nxt; cA = nA; cB = nB; ++ui;
        if (wr == 1) PG8_BAR;
    }
    PG8_WAIT_V(0);
    PG8_BAR;
#undef PG8_SA
#undef PG8_SB
#undef PG8_STAGE
#undef PG8_LDA
#undef PG8_LDB
#undef PG8_MMA
#undef PG8_WAIT_V
#undef PG8_WAIT_L
#undef PG8_BAR
#undef PG8_SCHED
}
template <class Epi>
__device__ __forceinline__ void gemm_phase8(PG8_LAS unsigned char* lds, const Gemm g, const Sched& S, const Epi& E, const int tid) {
    const int wid = __builtin_amdgcn_readfirstlane(tid >> 6), lane = tid & 63, wr = wid >> 2, wc = wid & 3, fr = lane & 15, fq = lane >> 4;
    const int K = g.K, nt = K / BK;
    unsigned voffA[2], voffB[2];
#pragma unroll
    for (int i = 0; i < 2; ++i) { int R, C; stage_rc(tid * 16 + i * 8192, R, C); const int Rb = ((R & ~31) + perm32(R & 31));
        voffA[i] = (unsigned)(R * g.lda + C) * 2u; voffB[i] = (unsigned)(Rb * g.ldb + C) * 2u; }
    const size_t kstep = (size_t)(BK * 2);
    const size_t hstepA = (size_t)HALF * g.lda * 2, hstepB = (size_t)HALF * g.ldb * 2;
    const size_t tstepA = 2 * hstepA, tstepB = 2 * hstepB;
    const unsigned ldsw = (unsigned)wid * 1024u;
    const int aoff0 = lds_byte(wr * 64 + fr, fq * 8), aoff1 = lds_byte(wr * 64 + fr, 32 + fq * 8), boff0 = lds_byte(wc * 32 + fr, fq * 8), boff1 = lds_byte(wc * 32 + fr, 32 + fq * 8);
#define PG8_SA(b, h) (((b) * 2 + (h)) * HTB)
#define PG8_SB(b, h) ((4 + (b) * 2 + (h)) * HTB)
#define PG8_STAGE(bufoff, gbase, voff) do { _Pragma("unroll") for (int _i = 0; _i < 2; ++_i) \
        __builtin_amdgcn_global_load_lds((const unsigned*)((const char*)(gbase) + (voff)[_i]), (PG8_LAS unsigned*)(lds + (bufoff) + ldsw + _i * 8192), 16, 0, 0); } while (0)
#define PG8_LDA(dst, b, h) do { _Pragma("unroll") for (int m = 0; m < 4; ++m) { const v4i_ lo_ = *(const PG8_LAS v4i_*)(lds + PG8_SA(b, h) + aoff0 + m * 2048), hi_ = *(const PG8_LAS v4i_*)(lds + PG8_SA(b, h) + aoff1 + m * 2048); dst[m] = __builtin_shufflevector(lo_, hi_, 0, 1, 2, 3, 4, 5, 6, 7); } } while (0)
#define PG8_LDB(dst, b, h) do { _Pragma("unroll") for (int n = 0; n < 2; ++n) { const v4i_ lo_ = *(const PG8_LAS v4i_*)(lds + PG8_SB(b, h) + boff0 + n * 2048), hi_ = *(const PG8_LAS v4i_*)(lds + PG8_SB(b, h) + boff1 + n * 2048); dst[n] = __builtin_shufflevector(lo_, hi_, 0, 1, 2, 3, 4, 5, 6, 7); } } while (0)
#define PG8_MMA(ai, bj, At, Bt) do { __builtin_amdgcn_s_setprio(1); _Pragma("unroll") for (int m = 0; m < 4; ++m) _Pragma("unroll") for (int n = 0; n < 2; ++n) \
        asm volatile("v_mfma_scale_f32_16x16x128_f8f6f4 %0, %1, %2, %0, %3, %3 op_sel_hi:[0,0,0]" : "+v"(acc[ai][bj][m][n]) : "v"(Bt[n]), "v"(At[m]), "v"(sc127)); __builtin_amdgcn_s_setprio(0); } while (0)
#define PG8_WAIT_V(n) asm volatile("s_waitcnt vmcnt(" #n ")" ::: "memory")
#define PG8_WAIT_L(n) asm volatile("s_waitcnt lgkmcnt(" #n ")" ::: "memory")
#define PG8_BAR __builtin_amdgcn_s_barrier()
#define PG8_SCHED __builtin_amdgcn_sched_barrier(0)
    Unit cur, nxt; int ui = 0;
    if (!S.next(0, cur)) return;
    f32x4 acc[2][2][4][2];
#pragma unroll
    for (int a = 0; a < 2; ++a)
#pragma unroll
        for (int b = 0; b < 2; ++b)
#pragma unroll
            for (int m = 0; m < 4; ++m)
#pragma unroll
                for (int n = 0; n < 2; ++n) acc[a][b][m][n] = (f32x4){0.f, 0.f, 0.f, 0.f};
    typedef int v4i_ __attribute__((ext_vector_type(4))); typedef int v8i_ __attribute__((ext_vector_type(8)));
    v8i_ At[4], B0[2], B1[2]; const int sc127 = 0x7f7f7f7f;
    const char* cA = (const char*)g.A + (size_t)cur.pm * tstepA; const char* cB = (const char*)g.Bt + (size_t)cur.pb * tstepB;
    PG8_STAGE(PG8_SB(0, 0), cB, voffB); PG8_STAGE(PG8_SB(0, 1), cB + hstepB, voffB); PG8_STAGE(PG8_SA(0, 0), cA, voffA); PG8_STAGE(PG8_SA(0, 1), cA + hstepA, voffA);
    if (wr == 1) PG8_BAR;
    PG8_WAIT_V(2); PG8_BAR;
    PG8_STAGE(PG8_SB(1, 0), cB + kstep, voffB); PG8_STAGE(PG8_SA(1, 0), cA + kstep, voffA); PG8_STAGE(PG8_SB(1, 1), cB + hstepB + kstep, voffB);
    PG8_WAIT_V(6); PG8_BAR;
    for (;;) {
        const bool has_next = S.next(ui + 1, nxt);
        const char* nA = has_next ? (const char*)g.A + (size_t)nxt.pm * tstepA : cA; const char* nB = has_next ? (const char*)g.Bt + (size_t)nxt.pb * tstepB : cB;
#pragma nounroll
        for (int t = 0; t < nt; t += 2) {
            const bool last = (t == nt - 2);
            const char* a1 = cA + (size_t)(t + 1) * kstep;
            const char* a2 = last ? nA : cA + (size_t)(t + 2) * kstep; const char* b2 = last ? nB : cB + (size_t)(t + 2) * kstep;
            const char* a3 = a2 + kstep; const char* b3 = b2 + kstep;
            PG8_LDB(B0, 0, 0); PG8_LDB(B1, 0, 1); PG8_SCHED; PG8_LDA(At, 0, 0); PG8_STAGE(PG8_SA(1, 1), a1 + hstepA, voffA);
            PG8_WAIT_V(8); PG8_WAIT_L(0); PG8_BAR; PG8_MMA(0, 0, At, B0); PG8_MMA(0, 1, At, B1); PG8_BAR; PG8_SCHED;
            PG8_LDA(At, 0, 1); PG8_STAGE(PG8_SB(0, 0), b2, voffB); PG8_STAGE(PG8_SB(0, 1), b2 + hstepB, voffB); PG8_STAGE(PG8_SA(0, 0), a2, voffA);
            PG8_WAIT_V(8); PG8_WAIT_L(0); PG8_BAR; PG8_MMA(1, 0, At, B0); PG8_MMA(1, 1, At, B1); PG8_BAR; PG8_SCHED;
            PG8_LDB(B0, 1, 0); PG8_LDB(B1, 1, 1); PG8_SCHED; PG8_LDA(At, 1, 0); PG8_STAGE(PG8_SA(0, 1), a2 + hstepA, voffA);
            PG8_WAIT_V(8); PG8_WAIT_L(0); PG8_BAR; PG8_MMA(0, 0, At, B0); PG8_MMA(0, 1, At, B1); PG8_BAR; PG8_SCHED;
            PG8_LDA(At, 1, 1); PG8_STAGE(PG8_SB(1, 0), b3, voffB); PG8_STAGE(PG8_SB(1, 1), b3 + hstepB, voffB); PG8_STAGE(PG8_SA(1, 0), a3, voffA);
            PG8_WAIT_V(8); PG8_WAIT_L(0); PG8_BAR; PG8_MMA(1, 0, At, B0); PG8_MMA(1, 1, At, B1); PG8_BAR; PG8_SCHED;
        }
        if (wr == 0) PG8_BAR;
        asm volatile("s_nop 15\n\ts_nop 15" ::: "memory");
        E(acc, cur, wr, wc, fr, fq);
#ifdef EPI_DUP
        if (__is_same(Epi, ::EpiBf16) || __is_same(Epi, ::EpiBf16S)) { asm volatile("" ::: "memory"); E(acc, cur, wr, wc, fr, fq); }
#endif
        if (!has_next) break;
#pragma unroll
        for (int a = 0; a < 2; ++a)
#pragma unroll
            for (int b = 0; b < 2; ++b)
#pragma unroll
                for (int m = 0; m < 4; ++m)
#pragma unroll
                    for (int n = 0; n < 2; ++n) acc[a][b][m][n] = (f32x4){0.f, 0.f, 0.f, 0.f};
        cur = nxt; cA = nA; cB = nB; ++ui;
        if (wr == 1) PG8_BAR;
    }
    PG8_WAIT_V(0);
    PG8_BAR;
#undef PG8_SA
#undef PG8_SB
#undef PG8_STAGE
#undef PG8_LDA
#undef PG8_LDB
#undef PG8_MMA
#undef PG8_WAIT_V
#undef PG8_WAIT_L
#undef PG8_BAR
#undef PG8_SCHED
}
template <class Epi>
__device__ __forceinline__ void gemm_phase_g(PG8_LAS unsigned char* lds, const Gemm g, const Sched& S, const Epi& E, const int tid, const PG8_LAS int* tab) {
    const int wid = __builtin_amdgcn_readfirstlane(tid >> 6), lane = tid & 63, wr = wid >> 2, wc = wid & 3, fr = lane & 15, fq = lane >> 4;
    const int K = g.K, nt = K / BK;
    unsigned voffB[2]; int RA0, CA0, RA1, CA1;
    {   int R, C; stage_rc(tid * 16, R, C); RA0 = R; CA0 = C; voffB[0] = (unsigned)(((R & ~31) + perm32(R & 31)) * g.ldb + C) * 2u;
        stage_rc(tid * 16 + 8192, R, C); RA1 = R; CA1 = C; voffB[1] = (unsigned)(((R & ~31) + perm32(R & 31)) * g.ldb + C) * 2u; }
    struct V2 { unsigned a, b; };
    V2 vA0, vA1, nA0, nA1;
#define PG8_GVOFF(d0, d1, ord) do { d0.a = (unsigned)(tab[(ord) * 256 + RA0] * g.lda + CA0) * 2u; d0.b = (unsigned)(tab[(ord) * 256 + RA1] * g.lda + CA1) * 2u; \
        d1.a = (unsigned)(tab[(ord) * 256 + 128 + RA0] * g.lda + CA0) * 2u; d1.b = (unsigned)(tab[(ord) * 256 + 128 + RA1] * g.lda + CA1) * 2u; } while (0)
#define PG8_STAGEA(bufoff, gbase, v2) do { \
        __builtin_amdgcn_global_load_lds((const unsigned*)((const char*)(gbase) + (v2).a), (PG8_LAS unsigned*)(lds + (bufoff) + ldsw), 16, 0, 0); \
        __builtin_amdgcn_global_load_lds((const unsigned*)((const char*)(gbase) + (v2).b), (PG8_LAS unsigned*)(lds + (bufoff) + ldsw + 8192), 16, 0, 0); } while (0)
    const size_t kstep = (size_t)(BK * 2);
    const size_t hstepB = (size_t)HALF * g.ldb * 2;
    const size_t tstepB = 2 * hstepB;
    const unsigned ldsw = (unsigned)wid * 1024u;
    const int aoff = lds_byte(wr * 64 + fr, fq * 8), boff = lds_byte(wc * 32 + fr, fq * 8);
#define PG8_SA(b, h) (((b) * 2 + (h)) * HTB)
#define PG8_SB(b, h) ((4 + (b) * 2 + (h)) * HTB)
#define PG8_STAGE(bufoff, gbase, voff) do { _Pragma("unroll") for (int _i = 0; _i < 2; ++_i) \
        __builtin_amdgcn_global_load_lds((const unsigned*)((const char*)(gbase) + (voff)[_i]), (PG8_LAS unsigned*)(lds + (bufoff) + ldsw + _i * 8192), 16, 0, 0); } while (0)
#define PG8_LDA(dst, b, h) do { _Pragma("unroll") for (int m = 0; m < 4; ++m) _Pragma("unroll") for (int k = 0; k < 2; ++k) dst[m][k] = *(const PG8_LAS bf16x8*)(lds + PG8_SA(b, h) + aoff + m * 2048 + k * 1024); } while (0)
#define PG8_LDB(dst, b, h) do { _Pragma("unroll") for (int n = 0; n < 2; ++n) _Pragma("unroll") for (int k = 0; k < 2; ++k) dst[n][k] = *(const PG8_LAS bf16x8*)(lds + PG8_SB(b, h) + boff + n * 2048 + k * 1024); } while (0)
#define PG8_MMA(ai, bj, At, Bt) do { __builtin_amdgcn_s_setprio(1); _Pragma("unroll") for (int m = 0; m < 4; ++m) _Pragma("unroll") for (int n = 0; n < 2; ++n) _Pragma("unroll") for (int k = 0; k < 2; ++k) \
        acc[ai][bj][m][n] = __builtin_amdgcn_mfma_f32_16x16x32_bf16(Bt[n][k], At[m][k], acc[ai][bj][m][n], 0, 0, 0); __builtin_amdgcn_s_setprio(0); } while (0)
#define PG8_WAIT_V(n) asm volatile("s_waitcnt vmcnt(" #n ")" ::: "memory")
#define PG8_WAIT_L(n) asm volatile("s_waitcnt lgkmcnt(" #n ")" ::: "memory")
#define PG8_BAR __builtin_amdgcn_s_barrier()
#define PG8_SCHED __builtin_amdgcn_sched_barrier(0)
    Unit cur, nxt; int ui = 0;
    if (!S.next(0, cur)) return;
    f32x4 acc[2][2][4][2];
#pragma unroll
    for (int a = 0; a < 2; ++a)
#pragma unroll
        for (int b = 0; b < 2; ++b)
#pragma unroll
            for (int m = 0; m < 4; ++m)
#pragma unroll
                for (int n = 0; n < 2; ++n) acc[a][b][m][n] = (f32x4){0.f, 0.f, 0.f, 0.f};
    bf16x8 At[4][2], B0[2][2], B1[2][2];
    PG8_GVOFF(vA0, vA1, 0);
    const char* cA = (const char*)g.A; const char* cB = (const char*)g.Bt + (size_t)cur.pb * tstepB;
    PG8_STAGE(PG8_SB(0, 0), cB, voffB); PG8_STAGE(PG8_SB(0, 1), cB + hstepB, voffB); PG8_STAGEA(PG8_SA(0, 0), cA, vA0); PG8_STAGEA(PG8_SA(0, 1), cA, vA1);
    if (wr == 1) PG8_BAR;
    PG8_WAIT_V(2); PG8_BAR;
    PG8_STAGE(PG8_SB(1, 0), cB + kstep, voffB); PG8_STAGEA(PG8_SA(1, 0), cA + kstep, vA0); PG8_STAGE(PG8_SB(1, 1), cB + hstepB + kstep, voffB);
    PG8_WAIT_V(6); PG8_BAR;
    for (;;) {
        const bool has_next = S.next(ui + 1, nxt);
        if (has_next) PG8_GVOFF(nA0, nA1, ui + 1); else { nA0 = vA0; nA1 = vA1; }
        const char* nA = cA; const char* nB = has_next ? (const char*)g.Bt + (size_t)nxt.pb * tstepB : cB;
#pragma nounroll
        for (int t = 0; t < nt; t += 2) {
            const bool last = (t == nt - 2);
            const char* a1 = cA + (size_t)(t + 1) * kstep;
            const char* a2 = last ? nA : cA + (size_t)(t + 2) * kstep; const char* b2 = last ? nB : cB + (size_t)(t + 2) * kstep;
            const char* a3 = a2 + kstep; const char* b3 = b2 + kstep;
            V2 s0, s1; s0.a = last ? nA0.a : vA0.a; s0.b = last ? nA0.b : vA0.b; s1.a = last ? nA1.a : vA1.a; s1.b = last ? nA1.b : vA1.b;
            PG8_LDB(B0, 0, 0); PG8_LDB(B1, 0, 1); PG8_SCHED; PG8_LDA(At, 0, 0); PG8_STAGEA(PG8_SA(1, 1), a1, vA1);
            PG8_WAIT_V(8); PG8_WAIT_L(0); PG8_BAR; PG8_MMA(0, 0, At, B0); PG8_MMA(0, 1, At, B1); PG8_BAR; PG8_SCHED;
            PG8_LDA(At, 0, 1); PG8_STAGE(PG8_SB(0, 0), b2, voffB); PG8_STAGE(PG8_SB(0, 1), b2 + hstepB, voffB); PG8_STAGEA(PG8_SA(0, 0), a2, s0);
            PG8_WAIT_V(8); PG8_WAIT_L(0); PG8_BAR; PG8_MMA(1, 0, At, B0); PG8_MMA(1, 1, At, B1); PG8_BAR; PG8_SCHED;
            PG8_LDB(B0, 1, 0); PG8_LDB(B1, 1, 1); PG8_SCHED; PG8_LDA(At, 1, 0); PG8_STAGEA(PG8_SA(0, 1), a2, s1);
            PG8_WAIT_V(8); PG8_WAIT_L(0); PG8_BAR; PG8_MMA(0, 0, At, B0); PG8_MMA(0, 1, At, B1); PG8_BAR; PG8_SCHED;
            PG8_LDA(At, 1, 1); PG8_STAGE(PG8_SB(1, 0), b3, voffB); PG8_STAGE(PG8_SB(1, 1), b3 + hstepB, voffB); PG8_STAGEA(PG8_SA(1, 0), a3, s0);
            PG8_WAIT_V(8); PG8_WAIT_L(0); PG8_BAR; PG8_MMA(1, 0, At, B0); PG8_MMA(1, 1, At, B1); PG8_BAR; PG8_SCHED;
        }
        if (wr == 0) PG8_BAR;
        E(acc, cur, wr, wc, fr, fq);
#ifdef EPI_DUP
        if (__is_same(Epi, ::EpiBf16) || __is_same(Epi, ::EpiBf16S)) { asm volatile("" ::: "memory"); E(acc, cur, wr, wc, fr, fq); }
#endif
        if (!has_next) break;
#pragma unroll
        for (int a = 0; a < 2; ++a)
#pragma unroll
            for (int b = 0; b < 2; ++b)
#pragma unroll
                for (int m = 0; m < 4; ++m)
#pragma unroll
                    for (int n = 0; n < 2; ++n) acc[a][b][m][n] = (f32x4){0.f, 0.f, 0.f, 0.f};
        cur = nxt; cB = nB; ++ui; vA0 = nA0; vA1 = nA1;
        if (wr == 1) PG8_BAR;
    }
    PG8_WAIT_V(0);
    PG8_BAR;
#undef PG8_GVOFF
#undef PG8_STAGEA
#undef PG8_SA
#undef PG8_SB
#undef PG8_STAGE
#undef PG8_LDA
#undef PG8_LDB
#undef PG8_MMA
#undef PG8_WAIT_V
#undef PG8_WAIT_L
#undef PG8_BAR
#undef PG8_SCHED
}
template <class Epi>
__device__ __forceinline__ void gemm_phase_g8(PG8_LAS unsigned char* lds, const Gemm g, const Sched& S, const Epi& E, const int tid, const PG8_LAS int* tab) {
    const int wid = __builtin_amdgcn_readfirstlane(tid >> 6), lane = tid & 63, wr = wid >> 2, wc = wid & 3, fr = lane & 15, fq = lane >> 4;
    const int K = g.K, nt = K / BK;
    unsigned voffB[2];
    {   int R, C; stage_rc(tid * 16, R, C); voffB[0] = (unsigned)(((R & ~31) + perm32(R & 31)) * g.ldb + C) * 2u;
        stage_rc(tid * 16 + 8192, R, C); voffB[1] = (unsigned)(((R & ~31) + perm32(R & 31)) * g.ldb + C) * 2u; }
    struct V2 { unsigned a, b; };
    V2 vA0, vA1;
#define PG8_GVOFF(d0, d1, ord) do { int R0_, C0_, R1_, C1_; stage_rc(tid * 16, R0_, C0_); stage_rc(tid * 16 + 8192, R1_, C1_); \
        d0.a = (unsigned)(tab[(ord) * 256 + R0_] * g.lda + C0_) * 2u; d0.b = (unsigned)(tab[(ord) * 256 + R1_] * g.lda + C1_) * 2u; \
        d1.a = (unsigned)(tab[(ord) * 256 + 128 + R0_] * g.lda + C0_) * 2u; d1.b = (unsigned)(tab[(ord) * 256 + 128 + R1_] * g.lda + C1_) * 2u; } while (0)
#define PG8_STAGEA(bufoff, gbase, v2) do { \
        __builtin_amdgcn_global_load_lds((const unsigned*)((const char*)(gbase) + (v2).a), (PG8_LAS unsigned*)(lds + (bufoff) + ldsw), 16, 0, 0); \
        __builtin_amdgcn_global_load_lds((const unsigned*)((const char*)(gbase) + (v2).b), (PG8_LAS unsigned*)(lds + (bufoff) + ldsw + 8192), 16, 0, 0); } while (0)
    const size_t kstep = (size_t)(BK * 2);
    const size_t hstepB = (size_t)HALF * g.ldb * 2;
    const size_t tstepB = 2 * hstepB;
    const unsigned ldsw = (unsigned)wid * 1024u;
    const int aoff0 = lds_byte(wr * 64 + fr, fq * 8), aoff1 = lds_byte(wr * 64 + fr, 32 + fq * 8), boff0 = lds_byte(wc * 32 + fr, fq * 8), boff1 = lds_byte(wc * 32 + fr, 32 + fq * 8);
#define PG8_SA(b, h) (((b) * 2 + (h)) * HTB)
#define PG8_SB(b, h) ((4 + (b) * 2 + (h)) * HTB)
#define PG8_STAGE(bufoff, gbase, voff) do { _Pragma("unroll") for (int _i = 0; _i < 2; ++_i) \
        __builtin_amdgcn_global_load_lds((const unsigned*)((const char*)(gbase) + (voff)[_i]), (PG8_LAS unsigned*)(lds + (bufoff) + ldsw + _i * 8192), 16, 0, 0); } while (0)
#define PG8_LDA(dst, b, h) do { _Pragma("unroll") for (int m = 0; m < 4; ++m) { const v4i_ lo_ = *(const PG8_LAS v4i_*)(lds + PG8_SA(b, h) + aoff0 + m * 2048), hi_ = *(const PG8_LAS v4i_*)(lds + PG8_SA(b, h) + aoff1 + m * 2048); dst[m] = __builtin_shufflevector(lo_, hi_, 0, 1, 2, 3, 4, 5, 6, 7); } } while (0)
#define PG8_LDB(dst, b, h) do { _Pragma("unroll") for (int n = 0; n < 2; ++n) { const v4i_ lo_ = *(const PG8_LAS v4i_*)(lds + PG8_SB(b, h) + boff0 + n * 2048), hi_ = *(const PG8_LAS v4i_*)(lds + PG8_SB(b, h) + boff1 + n * 2048); dst[n] = __builtin_shufflevector(lo_, hi_, 0, 1, 2, 3, 4, 5, 6, 7); } } while (0)
#define PG8_MMA(ai, bj, At, Bt) do { __builtin_amdgcn_s_setprio(1); _Pragma("unroll") for (int m = 0; m < 4; ++m) _Pragma("unroll") for (int n = 0; n < 2; ++n) \
        asm volatile("v_mfma_scale_f32_16x16x128_f8f6f4 %0, %1, %2, %0, %3, %3 op_sel_hi:[0,0,0]" : "+v"(acc[ai][bj][m][n]) : "v"(Bt[n]), "v"(At[m]), "v"(sc127)); __builtin_amdgcn_s_setprio(0); } while (0)
#define PG8_WAIT_V(n) asm volatile("s_waitcnt vmcnt(" #n ")" ::: "memory")
#define PG8_WAIT_L(n) asm volatile("s_waitcnt lgkmcnt(" #n ")" ::: "memory")
#define PG8_BAR __builtin_amdgcn_s_barrier()
#define PG8_SCHED __builtin_amdgcn_sched_barrier(0)
    Unit cur, nxt; int ui = 0;
    if (!S.next(0, cur)) return;
    f32x4 acc[2][2][4][2];
#pragma unroll
    for (int a = 0; a < 2; ++a)
#pragma unroll
        for (int b = 0; b < 2; ++b)
#pragma unroll
            for (int m = 0; m < 4; ++m)
#pragma unroll
                for (int n = 0; n < 2; ++n) acc[a][b][m][n] = (f32x4){0.f, 0.f, 0.f, 0.f};
    typedef int v4i_ __attribute__((ext_vector_type(4))); typedef int v8i_ __attribute__((ext_vector_type(8)));
    v8i_ At[4], B0[2], B1[2]; const int sc127 = 0x7f7f7f7f;
    PG8_GVOFF(vA0, vA1, 0);
    const char* cA = (const char*)g.A; const char* cB = (const char*)g.Bt + (size_t)cur.pb * tstepB;
    PG8_STAGE(PG8_SB(0, 0), cB, voffB); PG8_STAGE(PG8_SB(0, 1), cB + hstepB, voffB); PG8_STAGEA(PG8_SA(0, 0), cA, vA0); PG8_STAGEA(PG8_SA(0, 1), cA, vA1);
    if (wr == 1) PG8_BAR;
    PG8_WAIT_V(2); PG8_BAR;
    PG8_STAGE(PG8_SB(1, 0), cB + kstep, voffB); PG8_STAGEA(PG8_SA(1, 0), cA + kstep, vA0); PG8_STAGE(PG8_SB(1, 1), cB + hstepB + kstep, voffB);
    PG8_WAIT_V(6); PG8_BAR;
    for (;;) {
        const bool has_next = S.next(ui + 1, nxt);
        const char* nA = cA; const char* nB = has_next ? (const char*)g.Bt + (size_t)nxt.pb * tstepB : cB;
#pragma nounroll
        for (int t = 0; t < nt; t += 2) {
            const bool last = (t == nt - 2);
            const char* a1 = cA + (size_t)(t + 1) * kstep;
            const char* a2 = last ? nA : cA + (size_t)(t + 2) * kstep; const char* b2 = last ? nB : cB + (size_t)(t + 2) * kstep;
            const char* a3 = a2 + kstep; const char* b3 = b2 + kstep;
            V2 s0 = vA0, s1 = vA1; if (last && has_next) PG8_GVOFF(s0, s1, ui + 1);
            PG8_LDB(B0, 0, 0); PG8_LDB(B1, 0, 1); PG8_SCHED; PG8_LDA(At, 0, 0); PG8_STAGEA(PG8_SA(1, 1), a1, vA1);
            PG8_WAIT_V(8); PG8_WAIT_L(0); PG8_BAR; PG8_MMA(0, 0, At, B0); PG8_MMA(0, 1, At, B1); PG8_BAR; PG8_SCHED;
            PG8_LDA(At, 0, 1); PG8_STAGE(PG8_SB(0, 0), b2, voffB); PG8_STAGE(PG8_SB(0, 1), b2 + hstepB, voffB); PG8_STAGEA(PG8_SA(0, 0), a2, s0);
            PG8_WAIT_V(8); PG8_WAIT_L(0); PG8_BAR; PG8_MMA(1, 0, At, B0); PG8_MMA(1, 1, At, B1); PG8_BAR; PG8_SCHED;
            PG8_LDB(B0, 1, 0); PG8_LDB(B1, 1, 1); PG8_SCHED; PG8_LDA(At, 1, 0); PG8_STAGEA(PG8_SA(0, 1), a2, s1);
            PG8_WAIT_V(8); PG8_WAIT_L(0); PG8_BAR; PG8_MMA(0, 0, At, B0); PG8_MMA(0, 1, At, B1); PG8_BAR; PG8_SCHED;
            PG8_LDA(At, 1, 1); PG8_STAGE(PG8_SB(1, 0), b3, voffB); PG8_STAGE(PG8_SB(1, 1), b3 + hstepB, voffB); PG8_STAGEA(PG8_SA(1, 0), a3, s0);
            PG8_WAIT_V(8); PG8_WAIT_L(0); PG8_BAR; PG8_MMA(1, 0, At, B0); PG8_MMA(1, 1, At, B1); PG8_BAR; PG8_SCHED;
        }
        if (wr == 0) PG8_BAR;
        asm volatile("s_nop 15\n\ts_nop 15" ::: "memory");
        E(acc, cur, wr, wc, fr, fq);
#ifdef EPI_DUP
        if (__is_same(Epi, ::EpiBf16) || __is_same(Epi, ::EpiBf16S)) { asm volatile("" ::: "memory"); E(acc, cur, wr, wc, fr, fq); }
#endif
        if (!has_next) break;
#pragma unroll
        for (int a = 0; a < 2; ++a)
#pragma unroll
            for (int b = 0; b < 2; ++b)
#pragma unroll
                for (int m = 0; m < 4; ++m)
#pragma unroll
                    for (int n = 0; n < 2; ++n) acc[a][b][m][n] = (f32x4){0.f, 0.f, 0.f, 0.f};
        cur = nxt; cB = nB; ++ui; PG8_GVOFF(vA0, vA1, ui);
        if (wr == 1) PG8_BAR;
    }
    PG8_WAIT_V(0);
    PG8_BAR;
#undef PG8_GVOFF
#undef PG8_STAGEA
#undef PG8_SA
#undef PG8_SB
#undef PG8_STAGE
#undef PG8_LDA
#undef PG8_LDB
#undef PG8_MMA
#undef PG8_WAIT_V
#undef PG8_WAIT_L
#undef PG8_BAR
#undef PG8_SCHED
}
}

#define XB_TMO      128
#define XB_XCNT(j)  (256  + 64 * (j))
#define XB_XSUB(j)  (1280 + 64 * (j))
#define XB_XGEN(j)  (2304 + 64 * (j))
#define XB_TOP      3328
#define XB_TOPGEN   3392
#define XCD_BAR_WORDS 3456
#define XB_SPIN_CAP (1u << 21)
__device__ __forceinline__ unsigned xb_ld(unsigned* p)              { return __hip_atomic_load(p, __ATOMIC_RELAXED, __HIP_MEMORY_SCOPE_AGENT); }
__device__ __forceinline__ unsigned xb_add(unsigned* p, unsigned v) { return __hip_atomic_fetch_add(p, v, __ATOMIC_RELAXED, __HIP_MEMORY_SCOPE_AGENT); }
__device__ __forceinline__ unsigned xb_xcc_id() { return (unsigned)__builtin_amdgcn_s_getreg((3 << 11) | 20) & 0xFu; }
#define XB_SPIN(cond, bar) do { unsigned _sp = 0; while (cond) { __builtin_amdgcn_s_sleep(1); \
    if ((++_sp & 255u) == 0u) { if (xb_ld(&(bar)[XB_TMO])) break; if (_sp > XB_SPIN_CAP) { atomicAdd(&(bar)[XB_TMO], 1u); break; } } } } while (0)
struct XcdBarrier { unsigned* bar; unsigned x; volatile LAS unsigned* st; };
__device__ __forceinline__ XcdBarrier xcd_barrier_post(unsigned* bar, volatile LAS unsigned* st) {
    XcdBarrier b; b.bar = bar; b.x = xb_xcc_id(); b.st = st;
    if (threadIdx.x == 0) (void)xb_add(&bar[XB_XCNT(b.x)], 1u);
    return b;
}
__device__ __forceinline__ void xcd_barrier_complete(unsigned* bar, unsigned x, unsigned& nloc, unsigned& nx) {
    const unsigned G = gridDim.x * gridDim.y * gridDim.z;
    unsigned sum, cnt, mine, sp = 0u;
    for (;;) {
        sum = 0u; cnt = 0u; mine = 0u;
#pragma unroll
        for (unsigned j = 0; j < 16; ++j) { const unsigned c = xb_ld(&bar[XB_XCNT(j)]); sum += c; cnt += (c > 0u) ? 1u : 0u; mine = (j == x) ? c : mine; }
        if (sum == G) break;
        __builtin_amdgcn_s_sleep(1);
        if ((++sp & 255u) == 0u) { if (xb_ld(&bar[XB_TMO])) break; if (sp > XB_SPIN_CAP) { atomicAdd(&bar[XB_TMO], 1u); break; } }
    }
    nloc = mine > 0u ? mine : 1u; nx = cnt > 0u ? cnt : 1u;
}
template <bool FIRST>
__device__ __forceinline__ void xcd_barrier_t(const XcdBarrier& b) {
    asm volatile("s_waitcnt vmcnt(0)" ::: "memory");
    __syncthreads();
    if (threadIdx.x == 0) {
        unsigned* bar = b.bar;
        __builtin_amdgcn_s_waitcnt(0);
        unsigned nloc = b.st[0], nx = b.st[1];
        if (FIRST) { if (nloc == 0u) { xcd_barrier_complete(bar, b.x, nloc, nx); b.st[0] = nloc; b.st[1] = nx; } }
        const unsigned old = xb_add(&bar[XB_XSUB(b.x)], 1u);
        const unsigned gen = old / nloc;
        if (old + 1u == (gen + 1u) * nloc) {
            __builtin_amdgcn_fence(__ATOMIC_RELEASE, "agent");
            asm volatile("s_waitcnt vmcnt(0)" ::: "memory");
            const unsigned og = xb_add(&bar[XB_TOP], 1u);
            const unsigned tg = og / nx;
            if (og + 1u == (tg + 1u) * nx) xb_add(&bar[XB_TOPGEN], 1u);
            else XB_SPIN(xb_ld(&bar[XB_TOPGEN]) == tg, bar);
            __builtin_amdgcn_fence(__ATOMIC_ACQUIRE, "agent");
            xb_add(&bar[XB_XGEN(b.x)], 1u);
            asm volatile("s_waitcnt vmcnt(0)" ::: "memory");
        } else {
            XB_SPIN(xb_ld(&bar[XB_XGEN(b.x)]) == gen, bar);
            __builtin_amdgcn_fence(__ATOMIC_ACQUIRE, "agent");
            asm volatile("s_waitcnt vmcnt(0)" ::: "memory");
        }
    }
    __syncthreads();
}
#define EPI_LOOP_BEGIN \
    const int row0 = u.pm * 256 + wr * 64 + fr, col0 = u.pn * 256 + wc * 32 + 8 * fq; \
    _Pragma("unroll") for (int ai = 0; ai < 2; ++ai) _Pragma("unroll") for (int m = 0; m < 4; ++m) { const int row = row0 + ai * 128 + m * 16; \
    _Pragma("unroll") for (int bj = 0; bj < 2; ++bj) { const int col = col0 + bj * 128; const f32x4 v0 = acc[ai][bj][m][0], v1 = acc[ai][bj][m][1];
#define EPI_LOOP_END } }
typedef const f32x4 (&AccRef)[2][2][4][2];
__device__ __forceinline__ u32x4 pack8(f32x4 v0, f32x4 v1) { u32x4 w; w.x = cvt_pk_bf16(v0[0], v0[1]); w.y = cvt_pk_bf16(v0[2], v0[3]); w.z = cvt_pk_bf16(v1[0], v1[1]); w.w = cvt_pk_bf16(v1[2], v1[3]); return w; }
__device__ __forceinline__ f32x4 silu4(f32x4 v) { return (f32x4){siluf_(v[0]), siluf_(v[1]), siluf_(v[2]), siluf_(v[3])}; }

struct EpiBf16 {
    bf16* O; int ldc;
    __device__ __forceinline__ void operator()(AccRef acc, const pg8::Unit& u, int wr, int wc, int fr, int fq) const {
        EPI_LOOP_BEGIN *(u32x4*)(O + (size_t)row * ldc + col) = pack8(v0, v1); EPI_LOOP_END
    }
};
struct EpiResid {
    const float* XF; bf16* XB;
    __device__ __forceinline__ void operator()(AccRef acc, const pg8::Unit& u, int wr, int wc, int fr, int fq) const {
        const int row0 = u.pm * 256 + wr * 64 + fr, col0 = u.pn * 256 + wc * 32 + 8 * fq;
#pragma unroll
        for (int ai = 0; ai < 2; ++ai) {
            if (XF) { f32x4 ra[4][2][2];
#pragma unroll
                for (int m = 0; m < 4; ++m)
#pragma unroll
                    for (int bj = 0; bj < 2; ++bj) { const float* p = XF + (size_t)(row0 + ai * 128 + m * 16) * DM + col0 + bj * 128; ra[m][bj][0] = *(const f32x4*)p; ra[m][bj][1] = *(const f32x4*)(p + 4); }
#pragma unroll
                for (int m = 0; m < 4; ++m)
#pragma unroll
                    for (int bj = 0; bj < 2; ++bj) *(u32x4*)(XB + (size_t)(row0 + ai * 128 + m * 16) * DM + col0 + bj * 128) = pack8(ra[m][bj][0] + acc[ai][bj][m][0], ra[m][bj][1] + acc[ai][bj][m][1]); }
            else { u32x4 rb[4][2];
#pragma unroll
                for (int m = 0; m < 4; ++m)
#pragma unroll
                    for (int bj = 0; bj < 2; ++bj) rb[m][bj] = *(const u32x4*)(XB + (size_t)(row0 + ai * 128 + m * 16) * DM + col0 + bj * 128);
#pragma unroll
                for (int m = 0; m < 4; ++m)
#pragma unroll
                    for (int bj = 0; bj < 2; ++bj) { const u32x4 t = rb[m][bj]; const f32x4 a = (f32x4){bflo(t.x), bfhi(t.x), bflo(t.y), bfhi(t.y)}, b = (f32x4){bflo(t.z), bfhi(t.z), bflo(t.w), bfhi(t.w)};
                        *(u32x4*)(XB + (size_t)(row0 + ai * 128 + m * 16) * DM + col0 + bj * 128) = pack8(a + acc[ai][bj][m][0], b + acc[ai][bj][m][1]); } }
        }
    }
};
struct EpiF32 {
    float* C; int ldc;
    __device__ __forceinline__ void operator()(AccRef acc, const pg8::Unit& u, int wr, int wc, int fr, int fq) const {
        EPI_LOOP_BEGIN float* p = C + (size_t)row * ldc + col; *(f32x4*)p = v0; *(f32x4*)(p + 4) = v1; EPI_LOOP_END
    }
};
struct EpiEvenIn {
    bf16* QS; bf16* ZF; bf16* ZB; bf16* VI; bf16* GA; bf16* UP;
    __device__ __forceinline__ void operator()(AccRef acc, const pg8::Unit& u, int wr, int wc, int fr, int fq) const {
        const int sec = u.pn >> 1;
        EPI_LOOP_BEGIN
            const int cc = col & 511;
            if (sec == 0) *(u32x4*)(QS + (size_t)row * 512 + cc) = pack8(silu4(v0), silu4(v1));
            else if (sec == 1) *(u32x4*)(ZF + (size_t)row * 512 + cc) = pack8(v0, v1);
            else if (sec == 2) *(u32x4*)(ZB + (size_t)row * 512 + cc) = pack8(v0, v1);
            else if (sec == 3) *(u32x4*)(VI + (size_t)row * 512 + cc) = pack8(v0, v1);
            else if (sec == 4) *(u32x4*)(GA + (size_t)row * 512 + cc) = pack8(silu4(v0), silu4(v1));
            else *(u32x4*)(UP + ((size_t)(cc >> 4) * 512 + (row >> 6)) * 1280 + (row & 63) * 16 + (cc & 15)) = pack8(v0, v1);
        EPI_LOOP_END
    }
};
struct EpiS5Main {
    bf16* YG;
    __device__ __forceinline__ void operator()(AccRef acc, const pg8::Unit& u, int wr, int wc, int fr, int fq) const {
        EPI_LOOP_BEGIN
            const f32x4 g0 = (f32x4){gelu_tanh(v0[0]), gelu_tanh(v0[1]), gelu_tanh(v0[2]), gelu_tanh(v0[3])}, g1 = (f32x4){gelu_tanh(v1[0]), gelu_tanh(v1[1]), gelu_tanh(v1[2]), gelu_tanh(v1[3])};
            *(u32x4*)(YG + ((size_t)(row & 511) * 64 + (col >> 4)) * 512 + (row >> 9) * 16 + (col & 15)) = pack8(g0, g1);
        EPI_LOOP_END
    }
};
struct EpiGlu {
    const bf16* YG; const float* bias; bf16* MIX;
    __device__ __forceinline__ void operator()(AccRef acc, const pg8::Unit& u, int wr, int wc, int fr, int fq) const {
        const int row0_ = u.pm * 256 + wr * 64 + fr, col0_ = u.pn * 256 + wc * 32 + 8 * fq;
        f32x4 bs[2][2]; u32x4 yall[2][4][2];
#pragma unroll
        for (int bj = 0; bj < 2; ++bj) { bs[bj][0] = *(const f32x4*)(bias + col0_ + bj * 128); bs[bj][1] = *(const f32x4*)(bias + col0_ + bj * 128 + 4); }
#pragma unroll
        for (int ai = 0; ai < 2; ++ai)
#pragma unroll
            for (int m = 0; m < 4; ++m)
#pragma unroll
                for (int bj = 0; bj < 2; ++bj) yall[ai][m][bj] = *(const u32x4*)(YG + (size_t)(row0_ + ai * 128 + m * 16) * 512 + col0_ + bj * 128);
        EPI_LOOP_BEGIN
            const u32x4 yv = yall[ai][m][bj]; const f32x4 b0 = bs[bj][0], b1 = bs[bj][1];
            const f32x4 t0 = v0 + b0, t1 = v1 + b1;
            const f32x4 o0 = (f32x4){bflo(yv.x) * sigmoidf_(t0[0]), bfhi(yv.x) * sigmoidf_(t0[1]), bflo(yv.y) * sigmoidf_(t0[2]), bfhi(yv.y) * sigmoidf_(t0[3])};
            const f32x4 o1 = (f32x4){bflo(yv.z) * sigmoidf_(t1[0]), bfhi(yv.z) * sigmoidf_(t1[1]), bflo(yv.w) * sigmoidf_(t1[2]), bfhi(yv.w) * sigmoidf_(t1[3])};
            f32x4 q0_ = o0, q1_ = o1; for (int e_ = 0; e_ < 4; ++e_) { q0_[e_] = QM(q0_[e_]); q1_[e_] = QM(q1_[e_]); }
            *(u32x4*)(MIX + (size_t)row * DM + 512 + col) = pack8(q0_, q1_);
        EPI_LOOP_END
    }
};
struct EpiMoe1 {
    unsigned char* HID8; float sc;
    __device__ __forceinline__ void operator()(AccRef acc, const pg8::Unit& u, int wr, int wc, int fr, int fq) const {
        const int row0 = u.pm * 256 + wr * 64 + fr, col0 = u.pn * 128 + wc * 32 + 8 * fq;
#pragma unroll
        for (int ai = 0; ai < 2; ++ai)
#pragma unroll
            for (int m = 0; m < 4; ++m) { const int row = row0 + ai * 128 + m * 16;
                const f32x4 ag0 = acc[ai][0][m][0], ag1 = acc[ai][0][m][1], au0 = acc[ai][1][m][0], au1 = acc[ai][1][m][1];
                const float kt = -LOG2E * sc, kc = 0.25f / (sc * sc);
                const f32x4 t0 = ag0 * kt, t1 = ag1 * kt;
                const f32x4 e0 = (f32x4){__builtin_amdgcn_exp2f(t0[0]), __builtin_amdgcn_exp2f(t0[1]), __builtin_amdgcn_exp2f(t0[2]), __builtin_amdgcn_exp2f(t0[3])}, e1 = (f32x4){__builtin_amdgcn_exp2f(t1[0]), __builtin_amdgcn_exp2f(t1[1]), __builtin_amdgcn_exp2f(t1[2]), __builtin_amdgcn_exp2f(t1[3])};
                const f32x4 d0 = e0 * kc + kc, d1 = e1 * kc + kc;
                const f32x4 r0 = (f32x4){fast_rcp(d0[0]), fast_rcp(d0[1]), fast_rcp(d0[2]), fast_rcp(d0[3])}, r1 = (f32x4){fast_rcp(d1[0]), fast_rcp(d1[1]), fast_rcp(d1[2]), fast_rcp(d1[3])};
                const f32x4 h0 = (ag0 * au0) * r0, h1 = (ag1 * au1) * r1; u32x2 o; o.x = pk_fp8x4(h0[0], h0[1], h0[2], h0[3]); o.y = pk_fp8x4(h1[0], h1[1], h1[2], h1[3]);
                *(u32x2*)(HID8 + (size_t)row * FF + col0) = o; }
    }
};
struct EpiBf16S {
    bf16* O; int ldc; float sc;
    __device__ __forceinline__ void operator()(AccRef acc, const pg8::Unit& u, int wr, int wc, int fr, int fq) const {
        EPI_LOOP_BEGIN *(u32x4*)(O + (size_t)row * ldc + col) = pack8(v0 * sc, v1 * sc); EPI_LOOP_END
    }
};
struct EpiFp8S {
    unsigned char* O; int ldc; float sc;
    __device__ __forceinline__ void operator()(AccRef acc, const pg8::Unit& u, int wr, int wc, int fr, int fq) const {
        EPI_LOOP_BEGIN u32x2 o; f32x4 c0 = v0 * sc, c1 = v1 * sc;
            for (int e_ = 0; e_ < 4; ++e_) { c0[e_] = __builtin_amdgcn_fmed3f(c0[e_], -448.f, 448.f); c1[e_] = __builtin_amdgcn_fmed3f(c1[e_], -448.f, 448.f); }
            o.x = pk_fp8x4(c0[0], c0[1], c0[2], c0[3]); o.y = pk_fp8x4(c1[0], c1[1], c1[2], c1[3]); *(u32x2*)(O + (size_t)row * ldc + col) = o; EPI_LOOP_END
    }
};
struct EpiMoe2 {
    bf16* YS; const float* GATE;
    __device__ __forceinline__ void operator()(AccRef acc, const pg8::Unit& u, int wr, int wc, int fr, int fq) const {
        const float* gp = GATE + u.pm * 256 + wr * 64 + fr;
        EPI_LOOP_BEGIN const float gt = gp[ai * 128 + m * 16]; *(u32x4*)(YS + (size_t)row * DM + col) = pack8(v0 * gt, v1 * gt); EPI_LOOP_END
    }
};
constexpr size_t MiB = 1u << 20;
constexpr size_t al(size_t x) { return (x + 4095) & ~(size_t)4095; }
constexpr size_t WS_CTL = 0, CTL_BYTES = 64 * 1024;
constexpr size_t WS_WEI = 1 * MiB;
constexpr size_t WS_WOI = WS_WEI + al((size_t)2 * 3072 * 1024 * 2);
constexpr size_t WS_WEO = WS_WOI + al((size_t)2 * 3584 * 1024 * 2);
constexpr size_t WS_WOO = WS_WEO + al((size_t)2 * 1024 * 1024 * 2);
constexpr size_t WS_WGL = WS_WOO + al((size_t)2 * 1024 * 1024 * 2);
constexpr size_t WS_LB  = WS_WGL + al((size_t)2 * 512 * 512 * 2);
constexpr size_t WS_KTAB = WS_LB + al(2 * 2 * 512 * 4);
constexpr size_t WS_TW  = WS_KTAB + al((size_t)2 * 32 * 2 * 64 * 256 * 4);
constexpr size_t WS_SV  = WS_TW + al((size_t)2 * 32 * 1024 * 1280 * 2);
constexpr size_t WS_WGU = WS_SV + al((size_t)2 * 32 * 256 * 1024 * 2);
constexpr size_t WS_WD  = WS_WGU + al((size_t)16 * 4096 * 1024 * 2);
constexpr size_t WS_HN  = WS_WD + al((size_t)16 * 1024 * 2048 * 2);
constexpr size_t WS_MIX = WS_HN + al((size_t)T * DM * 2);
constexpr size_t WS_R   = WS_MIX + al((size_t)T * DM * 2);
constexpr size_t R_QD  = 0;
constexpr size_t R_KDT = R_QD + (size_t)2 * T * 512 * 2;
constexpr size_t R_VAL = R_KDT + (size_t)2 * T * 512 * 2;
constexpr size_t R_KC  = R_VAL + (size_t)2 * T * 512 * 2;
constexpr size_t R_AT  = R_KC + (size_t)2 * T * 512 * 2;
constexpr size_t R_DEC = R_AT + (size_t)32 * 128 * 4096 * 2;
constexpr size_t R_OS  = R_DEC + (size_t)32 * 128 * 128 * 4;
constexpr size_t R_SCAN_END = R_OS + (size_t)2 * T * 512 * 4;
constexpr size_t R_QS = R_SCAN_END;
constexpr size_t R_ZF = R_QS + (size_t)T * 512 * 2;
constexpr size_t R_ZB = R_ZF + (size_t)T * 512 * 4;
constexpr size_t R_VI = R_ZB + (size_t)T * 512 * 4;
constexpr size_t R_GA = R_VI + (size_t)T * 512 * 2;
constexpr size_t R_UP = R_GA + (size_t)T * 512 * 2;
constexpr size_t R_EB = R_UP + (size_t)16384 * 1280 * 2;
constexpr size_t R_YG = R_EB + (size_t)16384 * 256 * 4;
constexpr size_t R_EVEN_END = R_YG + (size_t)T * 512 * 2;
constexpr size_t R_PO = R_SCAN_END;
constexpr size_t R_AB = R_PO + (size_t)T * 3584 * 2;
constexpr size_t R_AQ = R_AB + (size_t)T * 16 * 4;
constexpr size_t R_AK = R_AQ + (size_t)T * 512 * 2;
constexpr size_t R_AVT = R_AK + (size_t)T * 512 * 2;
constexpr size_t R_AO = R_AVT + (size_t)T * 512 * 2;
constexpr size_t R_GQ = R_AO + (size_t)T * 1024 * 4;
constexpr size_t R_GK = R_GQ + (size_t)T * 512 * 2;
constexpr size_t R_GV = R_GK + (size_t)T * 512 * 2;
constexpr size_t R_GG = R_GV + (size_t)T * 512 * 2;
constexpr size_t R_GB = R_GG + (size_t)T * 8 * 4;
constexpr size_t R_ODD_END = R_GB + (size_t)T * 8 * 4;
constexpr size_t R_AFF = 0;
constexpr size_t R_SEL = R_AFF + (size_t)NB * NE * SEQ * 4;
constexpr size_t R_IDX = R_SEL + (size_t)T * 16 * 4;
constexpr size_t R_GATE = R_IDX + (size_t)NSLOT * 4;
constexpr size_t R_XG = R_GATE + (size_t)NSLOT * 4;
constexpr size_t R_HID = R_XG + (size_t)NSLOT * DM * 2;
constexpr size_t R_YS = R_HID + (size_t)NSLOT * FF * 2;
constexpr size_t R_MOE_END = R_YS + (size_t)NSLOT * DM * 2;
constexpr size_t R_MAX1 = R_EVEN_END > R_ODD_END ? R_EVEN_END : R_ODD_END;
constexpr size_t R_MAX = R_MAX1 > R_MOE_END ? R_MAX1 : R_MOE_END;
constexpr size_t WS_XB  = WS_R + R_MAX;
constexpr size_t WS_END = WS_XB + al((size_t)T * DM * 2);

constexpr int RING_BYTES = 147456, MISC_OFF = RING_BYTES + 320, LDS_BYTES = 151552;

struct Args { const float* in[32]; float* out; unsigned char* ws; };
enum { I_X = 0, I_MIXN, I_FFNN, I_EVWIN, I_EVWOUT, I_ALB, I_AOUTN, I_S5LRE, I_S5LIM, I_S5LS, I_S5BRE, I_S5BIM, I_S5CRE, I_S5CIM, I_S5D, I_S5GW, I_S5GB,
       I_ODWIN, I_ODWOUT, I_CQN, I_CKN, I_CLAM, I_COUTN, I_RELB, I_DCONV, I_DALOG, I_DDTB, I_DOUTN, I_ROUTER, I_WGATE, I_WUP, I_WDOWN };

constexpr int CW_Q = 4096;
__device__ __forceinline__ int wq_next(unsigned* ctr, volatile LAS unsigned* slot, int tid) {
    lds_barrier();
    if (tid == 0) *slot = __hip_atomic_fetch_add(ctr, 1u, __ATOMIC_RELAXED, __HIP_MEMORY_SCOPE_AGENT);
    lds_barrier();
    return (int)*slot;
}
__device__ __forceinline__ int wq_next_xcd(unsigned* ctr8, int xcd, int nper, volatile LAS unsigned* slot, int tid) {
    lds_barrier();
    if (tid == 0) { int r = -1;
        for (int k = 0; k < 8; ++k) { const int q = (xcd + k) & 7; const unsigned i = __hip_atomic_fetch_add(ctr8 + 64 * q, 1u, __ATOMIC_RELAXED, __HIP_MEMORY_SCOPE_AGENT); if ((int)i < nper) { r = q * nper + (int)i; break; } }
        *slot = (unsigned)r; }
    lds_barrier();
    return (int)*slot;
}
__device__ __forceinline__ void tr_item(const float* W, int ldw, bf16* WT, int Kd, int k0, int nsrc, int ndst, LAS float* scr, int lane, float qs = 0.f) {
    float rv[32];
    const float* wp = W + (size_t)(k0 + (lane >> 5)) * ldw + nsrc + (lane & 31);
#pragma unroll
    for (int i = 0; i < 32; ++i) rv[i] = wp[(size_t)(2 * i) * ldw];
#pragma unroll
    for (int i = 0; i < 32; ++i) scr[(2 * i + (lane >> 5)) * 33 + (lane & 31)] = rv[i];
    LDS_WAIT(); asm volatile("" ::: "memory");
    const int c = lane & 7;
#pragma unroll
    for (int j = 0; j < 4; ++j) { const int n = (lane >> 3) + 8 * j; const LAS float* s = scr + (8 * c) * 33 + n;
        float t_[8];
#pragma unroll
        for (int i_ = 0; i_ < 8; ++i_) { t_[i_] = s[i_ * 33]; if (qs != 0.f) t_[i_] = q8(t_[i_], qs); }
        u32x4 o; o.x = cvt_pk_bf16(t_[0], t_[1]); o.y = cvt_pk_bf16(t_[2], t_[3]); o.z = cvt_pk_bf16(t_[4], t_[5]); o.w = cvt_pk_bf16(t_[6], t_[7]);
        *(u32x4*)(WT + (size_t)(ndst + n) * Kd + k0 + 8 * c) = o; }
    LDS_WAIT(); asm volatile("" ::: "memory");
}

__device__ __forceinline__ void tr_item64(const float* W, int ldw, bf16* WT, int Kd, int k0, int nsrc, int ndst, LAS float* scr, int lane) {
    float rv[64];
    const float* wp = W + (size_t)k0 * ldw + nsrc + lane;
#pragma unroll
    for (int i = 0; i < 64; ++i) rv[i] = wp[(size_t)i * ldw];
#pragma unroll
    for (int i = 0; i < 64; ++i) scr[i * 65 + lane] = rv[i];
    LDS_WAIT(); asm volatile("" ::: "memory");
    const int c = lane & 7;
#pragma unroll
    for (int j = 0; j < 8; ++j) { const int n = (lane >> 3) + 8 * j; const LAS float* s = scr + (8 * c) * 65 + n;
        u32x4 o; o.x = cvt_pk_bf16(s[0 * 65], s[1 * 65]); o.y = cvt_pk_bf16(s[2 * 65], s[3 * 65]); o.z = cvt_pk_bf16(s[4 * 65], s[5 * 65]); o.w = cvt_pk_bf16(s[6 * 65], s[7 * 65]);
        *(u32x4*)(WT + (size_t)(ndst + n) * Kd + k0 + 8 * c) = o; }
    LDS_WAIT(); asm volatile("" ::: "memory");
}
struct Cplx { float re, im; };
__device__ __forceinline__ Cplx cmul(Cplx a, Cplx b) { return Cplx{a.re * b.re - a.im * b.im, a.re * b.im + a.im * b.re}; }
__device__ __forceinline__ void s5_disc(const Args& A, int jd, int g, int n, Cplx& th, Cplx& f) {
    const int ix = (jd * 32 + g) * 64 + n;
    const float lre = A.in[I_S5LRE][ix], lim = A.in[I_S5LIM][ix], step = expf(A.in[I_S5LS][jd * 32 + g]);
    th.re = lre * step; th.im = lim * step;
    const float mag = expf(th.re); float sn, cs; sincosf(th.im, &sn, &cs);
    const float are = mag * cs, aim = mag * sn, den = lre * lre + lim * lim;
    f.re = ((are - 1.f) * lre + aim * lim) / den; f.im = (aim * lre - (are - 1.f) * lim) / den;
}
__device__ __forceinline__ Cplx s5_pow(Cplx th, float m) { const float mag = expf(m * th.re); float sn, cs; sincosf(m * th.im, &sn, &cs); return Cplx{mag * cs, mag * sn}; }

__device__ __forceinline__ void s5_ktab_item(const Args& A, float* KTAB, int item, LAS float* scr, int lane) {
    const int lag = item & 63, g = (item >> 6) & 31, jd = item >> 11;
    Cplx th, f; s5_disc(A, jd, g, lane, th, f);
    const Cplx w = cmul(s5_pow(th, (float)lag), f);
    scr[lane] = w.re; scr[64 + lane] = w.im;
    LDS_WAIT(); asm volatile("" ::: "memory");
    const float* cre = A.in[I_S5CRE] + (size_t)(jd * 32 + g) * 1024; const float* cim = A.in[I_S5CIM] + (size_t)(jd * 32 + g) * 1024;
    const float* bre = A.in[I_S5BRE] + (size_t)(jd * 32 + g) * 1024; const float* bim = A.in[I_S5BIM] + (size_t)(jd * 32 + g) * 1024;
#pragma unroll
    for (int i = 0; i < 4; ++i) { const int e = lane + 64 * i, p = e >> 4, pp = e & 15; float acc = 0.f;
        for (int n = 0; n < 64; ++n) { const float wr_ = scr[n], wi_ = scr[64 + n], cr = cre[p * 64 + n], ci = cim[p * 64 + n];
            const float gr = cr * wr_ - ci * wi_, gi = cr * wi_ + ci * wr_; acc += gr * bre[n * 16 + pp] - gi * bim[n * 16 + pp]; }
        KTAB[((size_t)item) * 256 + e] = acc; }
    LDS_WAIT(); asm volatile("" ::: "memory");
}
__device__ __forceinline__ void s5_tw_unit(const Args& A, const float* KTAB, bf16* TW, int unit, int tid, LAS float* scr) {
    const int i = unit & 63, g = (unit >> 6) & 31, j = unit >> 11;
    __syncthreads();
    if (tid < 128) { const int dir = tid >> 6, n = tid & 63; Cplx th, f; s5_disc(A, j * 2 + dir, g, n, th, f); const Cplx ap = s5_pow(th, dir == 0 ? (float)(i + 1) : (float)(64 - i)); scr[tid * 2] = ap.re; scr[tid * 2 + 1] = ap.im; }
    __syncthreads();
#pragma unroll
    for (int it = tid; it < 16 * 160; it += 512) { const int p = it / 160, oc = it % 160, k0 = oc * 8; float v[8];
        if (k0 < 1024) { const int jp = k0 >> 4, pp0 = k0 & 15, lag = i - jp;
            if (lag != 0) { const int dir = lag > 0 ? 0 : 1, al_ = lag > 0 ? lag : -lag; const float* kt = KTAB + ((size_t)(((j * 2 + dir) * 32 + g) * 64 + al_)) * 256 + p * 16 + pp0;
#pragma unroll
                for (int e = 0; e < 8; ++e) v[e] = kt[e]; }
            else { const float* k0p = KTAB + ((size_t)(((j * 2 + 0) * 32 + g) * 64)) * 256 + p * 16 + pp0; const float* k1p = KTAB + ((size_t)(((j * 2 + 1) * 32 + g) * 64)) * 256 + p * 16 + pp0;
#pragma unroll
                for (int e = 0; e < 8; ++e) v[e] = k0p[e] + k1p[e] + ((pp0 + e == p) ? A.in[I_S5D][j * 512 + g * 16 + p] : 0.f); }
        } else { const int c0 = k0 - 1024, q = c0 >> 6, dir = q >> 1, jd = j * 2 + dir;
#pragma unroll
            for (int e = 0; e < 8; ++e) { const int n = (c0 & 63) + e; const Cplx ap = Cplx{scr[(dir * 64 + n) * 2], scr[(dir * 64 + n) * 2 + 1]};
                const int cix = ((jd * 32 + g) * 16 + p) * 64 + n; const Cplx G = cmul(Cplx{A.in[I_S5CRE][cix], A.in[I_S5CIM][cix]}, ap);
                v[e] = (q & 1) ? -G.im : G.re; } }
        u32x4 o; o.x = cvt_pk_bf16(v[0], v[1]); o.y = cvt_pk_bf16(v[2], v[3]); o.z = cvt_pk_bf16(v[4], v[5]); o.w = cvt_pk_bf16(v[6], v[7]);
        *(u32x4*)(TW + ((size_t)((j * 32 + g) * 1024 + i * 16 + p)) * 1280 + k0) = o; }
}
__device__ __forceinline__ void s5_sv_unit(const Args& A, bf16* SV, int unit, int tid) {
    const int q = unit & 3, g = (unit >> 2) & 31, j = unit >> 7, dir = q >> 1, jd = j * 2 + dir;
    for (int it = tid; it < 64 * 128; it += 512) { const int n = it >> 7, oc = it & 127, jp = oc >> 1, pp0 = (oc & 1) * 8;
        Cplx th, f; s5_disc(A, jd, g, n, th, f); const Cplx w = cmul(s5_pow(th, dir == 0 ? (float)(63 - jp) : (float)jp), f);
        const int bix = ((jd * 32 + g) * 64 + n) * 16 + pp0; float v[8];
#pragma unroll
        for (int e = 0; e < 8; ++e) { const Cplx bb = cmul(w, Cplx{A.in[I_S5BRE][bix + e], A.in[I_S5BIM][bix + e]}); v[e] = (q & 1) ? bb.im : bb.re; }
        u32x4 o; o.x = cvt_pk_bf16(v[0], v[1]); o.y = cvt_pk_bf16(v[2], v[3]); o.z = cvt_pk_bf16(v[4], v[5]); o.w = cvt_pk_bf16(v[6], v[7]);
        *(u32x4*)(SV + ((size_t)((j * 32 + g) * 256 + q * 64 + n)) * 1024 + jp * 16 + pp0) = o; }
}
__device__ __forceinline__ void s5_carry(const Args& A, int j, const float* EB, bf16* UP, int gtid) {
    const int n = gtid & 63, dir = (gtid >> 6) & 1, g = (gtid >> 7) & 31, b = gtid >> 12;
    Cplx th, f; s5_disc(A, j * 2 + dir, g, n, th, f); const Cplx a64 = s5_pow(th, 64.f);
    Cplx x{0.f, 0.f};
#pragma nounroll
    for (int c0 = 0; c0 < NCH; c0 += 16) {
        float er[16], ei[16];
#pragma unroll
        for (int u = 0; u < 16; ++u) { const int cc = c0 + u, c = dir == 0 ? cc : NCH - 1 - cc; const size_t row = (size_t)g * 512 + b * NCH + c;
            er[u] = EB[row * 256 + dir * 128 + n]; ei[u] = EB[row * 256 + dir * 128 + 64 + n]; }
#pragma unroll
        for (int u = 0; u < 16; ++u) { const int cc = c0 + u, c = dir == 0 ? cc : NCH - 1 - cc; const size_t row = (size_t)g * 512 + b * NCH + c;
            UP[row * 1280 + 1024 + dir * 128 + n] = f2bf(x.re); UP[row * 1280 + 1024 + dir * 128 + 64 + n] = f2bf(x.im);
            const Cplx ax = cmul(a64, x); x.re = ax.re + er[u]; x.im = ax.im + ei[u]; } }
}
__device__ __forceinline__ void norm_fill_w(LAS float* Wt, const float* W16, int ldw, int tid) {
#pragma unroll
    for (int hb = 0; hb < 2; ++hb) { float wv[16];
#pragma unroll
        for (int i = 0; i < 16; ++i) { const int idx = tid + 512 * (16 * hb + i), k = idx >> 4, e = idx & 15; wv[i] = W16[(size_t)k * ldw + e]; }
#pragma unroll
        for (int i = 0; i < 16; ++i) { const int idx = tid + 512 * (16 * hb + i), k = idx >> 4, e = idx & 15; Wt[e * 1028 + k] = wv[i]; } }
}
__device__ __forceinline__ void router_finish(const float (&a16)[16], int mode, float* OUT16, int row, int lane) {
#define RS_DPP(x, ctl) __int_as_float(__builtin_amdgcn_update_dpp(0, __float_as_int(x), ctl, 0xf, 0xf, true))
#define RS_SWZ(x, pat) __int_as_float(__builtin_amdgcn_ds_swizzle(__float_as_int(x), pat))
    const bool b0 = (lane & 1) != 0, b1 = (lane & 2) != 0, b2 = (lane & 4) != 0, b3 = (lane & 8) != 0;
        float r8[8], r4[4], r2[2];
#pragma unroll
        for (int i = 0; i < 8; ++i) { const float keep = b0 ? a16[i + 8] : a16[i], send = b0 ? a16[i] : a16[i + 8]; r8[i] = keep + RS_DPP(send, 0xB1); }
#pragma unroll
        for (int i = 0; i < 4; ++i) { const float keep = b1 ? r8[i + 4] : r8[i], send = b1 ? r8[i] : r8[i + 4]; r4[i] = keep + RS_DPP(send, 0x4E); }
#pragma unroll
        for (int i = 0; i < 2; ++i) { const float keep = b2 ? r4[i + 2] : r4[i], send = b2 ? r4[i] : r4[i + 2]; r2[i] = keep + RS_SWZ(send, 0x101F); }
        float lgv; { const float keep = b3 ? r2[1] : r2[0], send = b3 ? r2[0] : r2[1]; lgv = keep + RS_SWZ(send, 0x201F); }
        lgv += RS_SWZ(lgv, 0x401F);
        lgv += shfl_xor32(lgv, lane);
        const int eidx = ((lane & 1) << 3) | ((lane & 2) << 1) | ((lane & 4) >> 1) | ((lane & 8) >> 3);
        float outv = lgv;
        if (mode == 1) {
            float mx = lgv; mx = fmaxf(mx, RS_DPP(mx, 0xB1)); mx = fmaxf(mx, RS_DPP(mx, 0x4E)); mx = fmaxf(mx, RS_DPP(mx, 0x141)); mx = fmaxf(mx, RS_DPP(mx, 0x140));
            const float pe = fast_exp(lgv - mx); float sm = pe; sm += RS_DPP(sm, 0xB1); sm += RS_DPP(sm, 0x4E); sm += RS_DPP(sm, 0x141); sm += RS_DPP(sm, 0x140);
            outv = pe * (1.f / sm); }
#undef RS_DPP
#undef RS_SWZ
        if (lane < 16) { if (mode == 1) { const int b = row >> 13, l = row & (SEQ - 1); OUT16[((size_t)(b * NE + eidx)) * SEQ + l] = outv; } else OUT16[(size_t)row * 16 + eidx] = outv; }
}
__device__ __forceinline__ void row_norm_tail(f32x4 (&v)[4], const f32x4 (&gn)[4], bf16* HN, int mode, const LAS float* Wt, float* OUT16, int row, int lane) {
    float ss = 0.f;
#pragma unroll
    for (int jj = 0; jj < 4; ++jj) ss += (v[jj][0] * v[jj][0] + v[jj][1] * v[jj][1]) + (v[jj][2] * v[jj][2] + v[jj][3] * v[jj][3]);
    const float rstd = 1.f / sqrtf(wave_sum(ss) * (1.f / DM) + EPS);
    bf16* orow = HN + (size_t)row * DM + 4 * lane;
#pragma unroll
    for (int jj = 0; jj < 4; ++jj) { v[jj] = v[jj] * rstd * gn[jj];
        if (mode == 1) *(unsigned*)((unsigned char*)HN + (size_t)row * DM + 256 * jj + 4 * lane) = pk_fp8x4(v[jj][0] * 8.f, v[jj][1] * 8.f, v[jj][2] * 8.f, v[jj][3] * 8.f);
        else {
#if defined(EMU2) && (EMU2 & 2)
            for (int e_ = 0; e_ < 4; ++e_) v[jj][e_] = q8(v[jj][e_], 16.f);
#endif
            u32x2 o; o.x = cvt_pk_bf16(v[jj][0], v[jj][1]); o.y = cvt_pk_bf16(v[jj][2], v[jj][3]); *(u32x2*)(orow + 256 * jj) = o; } }
    if (mode) {
        float a16[16];
        f32x4 wc[4], wn[4];
#pragma unroll
        for (int jj = 0; jj < 4; ++jj) wc[jj] = *(const LAS f32x4*)(Wt + 256 * jj + 4 * lane);
#pragma unroll
        for (int e = 0; e < 16; ++e) { float a = 0.f;
            if (e + 1 < 16) {
#pragma unroll
                for (int jj = 0; jj < 4; ++jj) wn[jj] = *(const LAS f32x4*)(Wt + (e + 1) * 1028 + 256 * jj + 4 * lane); }
#pragma unroll
            for (int jj = 0; jj < 4; ++jj) { const f32x4 w = wc[jj]; a += (v[jj][0] * w[0] + v[jj][1] * w[1]) + (v[jj][2] * w[2] + v[jj][3] * w[3]); }
            a16[e] = a;
#pragma unroll
            for (int jj = 0; jj < 4; ++jj) wc[jj] = wn[jj];
            __builtin_amdgcn_sched_barrier(0); }
        router_finish(a16, mode, OUT16, row, lane);
    }
}
__device__ __forceinline__ f32x4 ld_row4(const float* p) { return *(const f32x4*)p; }
__device__ __forceinline__ f32x4 ld_row4(const bf16* p) { const u32x2 t = *(const u32x2*)p; return (f32x4){bflo(t.x), bfhi(t.x), bflo(t.y), bfhi(t.y)}; }
__device__ __forceinline__ void norm1_pair(f32x4 (&v0)[4], f32x4 (&v1)[4], const f32x4 (&gn)[4], unsigned char* HN8, const LAS float* Wt, float* AFFo, int row0, int row1, int lane) {
    float s0 = 0.f, s1 = 0.f;
#pragma unroll
    for (int jj = 0; jj < 4; ++jj) { s0 += (v0[jj][0] * v0[jj][0] + v0[jj][1] * v0[jj][1]) + (v0[jj][2] * v0[jj][2] + v0[jj][3] * v0[jj][3]); s1 += (v1[jj][0] * v1[jj][0] + v1[jj][1] * v1[jj][1]) + (v1[jj][2] * v1[jj][2] + v1[jj][3] * v1[jj][3]); }
    const float rs0 = 1.f / sqrtf(wave_sum(s0) * (1.f / DM) + EPS), rs1 = 1.f / sqrtf(wave_sum(s1) * (1.f / DM) + EPS);
#pragma unroll
    for (int jj = 0; jj < 4; ++jj) { v0[jj] = v0[jj] * rs0 * gn[jj]; v1[jj] = v1[jj] * rs1 * gn[jj];
        *(unsigned*)(HN8 + (size_t)row0 * DM + 256 * jj + 4 * lane) = pk_fp8x4(v0[jj][0] * 8.f, v0[jj][1] * 8.f, v0[jj][2] * 8.f, v0[jj][3] * 8.f);
        *(unsigned*)(HN8 + (size_t)row1 * DM + 256 * jj + 4 * lane) = pk_fp8x4(v1[jj][0] * 8.f, v1[jj][1] * 8.f, v1[jj][2] * 8.f, v1[jj][3] * 8.f); }
    float a0[16], a1[16];
    f32x4 wc[4], wn[4];
#pragma unroll
    for (int jj = 0; jj < 4; ++jj) wc[jj] = *(const LAS f32x4*)(Wt + 256 * jj + 4 * lane);
#pragma unroll
    for (int e = 0; e < 16; ++e) { f32x2 acc = (f32x2){0.f, 0.f};
        if (e + 1 < 16) {
#pragma unroll
            for (int jj = 0; jj < 4; ++jj) wn[jj] = *(const LAS f32x4*)(Wt + (e + 1) * 1028 + 256 * jj + 4 * lane); }
#pragma unroll
        for (int jj = 0; jj < 4; ++jj) { const f32x4 w = wc[jj];
            acc += ((f32x2){v0[jj][0], v1[jj][0]} * w[0] + (f32x2){v0[jj][1], v1[jj][1]} * w[1]) + ((f32x2){v0[jj][2], v1[jj][2]} * w[2] + (f32x2){v0[jj][3], v1[jj][3]} * w[3]); }
        a0[e] = acc[0]; a1[e] = acc[1];
#pragma unroll
        for (int jj = 0; jj < 4; ++jj) wc[jj] = wn[jj];
        __builtin_amdgcn_sched_barrier(0); }
    router_finish(a0, 1, AFFo, row0, lane);
    router_finish(a1, 1, AFFo, row1, lane);
}
template <class XT>
__device__ __forceinline__ void norm_phase(LAS unsigned char* lds, const XT* X, const float* gain, bf16* HN, int mode, const float* W16, int ldw, float* OUT16, int vcu, int G, int tid) {
    const int lane = tid & 63, wave = tid >> 6;
    LAS float* Wt = (LAS float*)lds;
    if (mode) norm_fill_w(Wt, W16, ldw, tid);
    __syncthreads();
    f32x4 gn[4];
#pragma unroll
    for (int jj = 0; jj < 4; ++jj) gn[jj] = *(const f32x4*)(gain + 256 * jj + 4 * lane);
    f32x4 vn[4];
    {   const int r0 = vcu * 8 + wave; const XT* xr0 = X + (size_t)(r0 < T ? r0 : 0) * DM + 4 * lane;
#pragma unroll
        for (int jj = 0; jj < 4; ++jj) vn[jj] = ld_row4(xr0 + 256 * jj); }
    if (mode == 1 && (T % (2 * G * 8)) == 0) {
        const int st = G * 8; f32x4 vm[4];
        {   const XT* xr1 = X + (size_t)(vcu * 8 + wave + st) * DM + 4 * lane;
#pragma unroll
            for (int jj = 0; jj < 4; ++jj) vm[jj] = ld_row4(xr1 + 256 * jj); }
        for (int row = vcu * 8 + wave; row < T; row += 2 * st) {
            f32x4 v0[4], v1[4];
            const int rnx = row + 2 * st; const XT* xa = X + (size_t)(rnx < T ? rnx : row) * DM + 4 * lane; const XT* xb = xa + (size_t)st * DM;
#pragma unroll
            for (int jj = 0; jj < 4; ++jj) { v0[jj] = vn[jj]; v1[jj] = vm[jj]; vn[jj] = ld_row4(xa + 256 * jj); vm[jj] = ld_row4(xb + 256 * jj); }
            norm1_pair(v0, v1, gn, (unsigned char*)HN, Wt, OUT16, row, row + st, lane);
        }
    } else
    for (int row = vcu * 8 + wave; row < T; row += G * 8) {
        f32x4 v[4];
        const int rnx = row + G * 8; const XT* xrn = X + (size_t)(rnx < T ? rnx : row) * DM + 4 * lane;
#pragma unroll
        for (int jj = 0; jj < 4; ++jj) { v[jj] = vn[jj]; vn[jj] = ld_row4(xrn + 256 * jj); }
        row_norm_tail(v, gn, HN, mode, Wt, OUT16, row, lane);
    }
    __syncthreads();
}

__device__ __forceinline__ void topk_unit(LAS unsigned char* lds, const float* AFF, int* SEL, int* IDX, float* GATE, int unit, int tid) {
    const int b = unit >> 4, e = unit & 15, lane = tid & 63, wave = tid >> 6;
    LAS unsigned* keys = (LAS unsigned*)lds;
    LAS unsigned* hist = keys + 8192;
    LAS unsigned* misc = hist + 256;
    const unsigned* src = (const unsigned*)(AFF + (size_t)unit * SEQ);
    unsigned mk[16];
#pragma unroll
    for (int i = 0; i < 16; ++i) mk[i] = src[tid * 16 + i];
    unsigned vsel = 0u;
    for (int bit = 30; bit >= 0; --bit) { const unsigned cand = vsel | (1u << bit); float cnt = 0.f;
#pragma unroll
        for (int i = 0; i < 16; ++i) cnt += (mk[i] >= cand) ? 1.f : 0.f;
        cnt = wave_sum(cnt);
        LAS float* part = (LAS float*)(misc + 64 + 8 * (bit & 1));
        if (lane == 0) part[wave] = cnt;
        __syncthreads();
        const float tot = ((part[0] + part[1]) + (part[2] + part[3])) + ((part[4] + part[5]) + (part[6] + part[7]));
        if (tot >= (float)CAP) vsel = cand; }
    unsigned need;
    {   float cnt = 0.f;
#pragma unroll
        for (int i = 0; i < 16; ++i) cnt += (mk[i] > vsel) ? 1.f : 0.f;
        cnt = wave_sum(cnt);
        LAS float* part = (LAS float*)(misc + 96);
        if (lane == 0) part[wave] = cnt;
        __syncthreads();
        const float tot = ((part[0] + part[1]) + (part[2] + part[3])) + ((part[4] + part[5]) + (part[6] + part[7]));
        need = (unsigned)CAP - (unsigned)tot; }
    const unsigned prefix = vsel;
    const unsigned Tk = prefix;
    unsigned cg = 0u, ce = 0u;
#pragma unroll
    for (int i = 0; i < 16; ++i) { cg += (mk[i] > Tk) ? 1u : 0u; ce += (mk[i] == Tk) ? 1u : 0u; }
    unsigned sg = cg, se = ce;
#pragma unroll
    for (int o = 1; o < 64; o <<= 1) { const unsigned tg = shfl_up_u(sg, o, lane), te = shfl_up_u(se, o, lane); if (lane >= o) { sg += tg; se += te; } }
    if (lane == 63) { misc[16 + wave] = sg; misc[32 + wave] = se; }
    __syncthreads();
    unsigned og = sg - cg, oe = se - ce;
    for (int w = 0; w < wave; ++w) { og += misc[16 + w]; oe += misc[32 + w]; }
    const size_t sbase = ((size_t)(e * NB + b)) * CAP;
#pragma unroll
    for (int i = 0; i < 16; ++i) { const int tok = tid * 16 + i; const bool isg = mk[i] > Tk, ise = mk[i] == Tk; const bool sel = isg || (ise && oe < need);
        const unsigned r = og + (oe < need ? oe : need);
        if (sel) { IDX[sbase + r] = tok; GATE[sbase + r] = __uint_as_float(mk[i]); }
        SEL[((size_t)(b * SEQ + tok)) * 16 + e] = sel ? (int)r : -1;
        og += isg ? 1u : 0u; oe += ise ? 1u : 0u; }
    __syncthreads();
}

__device__ __forceinline__ void gather_phase(const bf16* HN, const int* IDX, bf16* XG, int gw, int NGW, int lane) {
    for (int blk = gw; blk < NSLOT / 32; blk += NGW) { const int base = blk * 32, b = (base >> 10) & 3; const int idxv = IDX[base + (lane & 31)];
#pragma unroll 8
        for (int k = 0; k < 32; ++k) { const int tok = __builtin_amdgcn_readlane(idxv, k);
            const u32x4* s = (const u32x4*)(HN + ((size_t)(b * SEQ + tok)) * DM); u32x4* d = (u32x4*)(XG + (size_t)(base + k) * DM);
            const u32x4 a = s[lane], c = s[64 + lane]; d[lane] = a; d[64 + lane] = c; } }
}
__device__ __forceinline__ void combine_phase(LAS unsigned char* lds, bf16* XB, float* XOUT  , const int* SEL, const float* GATE, const unsigned char* YS  , int nmode, const float* gain, bf16* HN, const float* W16, int ldw, float* OUT16, int gw, int NGW, int tid) {
    const int lane = tid & 63;
    LAS float* Wt = (LAS float*)lds;
    if (nmode > 0) norm_fill_w(Wt, W16, ldw, tid);
    __syncthreads();
    f32x4 gn[4];
#pragma unroll
    for (int jj = 0; jj < 4; ++jj) gn[jj] = nmode >= 0 ? *(const f32x4*)(gain + 256 * jj + 4 * lane) : (f32x4){0.f, 0.f, 0.f, 0.f};
    for (int row0 = gw; row0 < T; row0 += 2 * NGW) {
        const int rows[2] = {row0, row0 + NGW < T ? row0 + NGW : row0}; const bool two = row0 + NGW < T;
        int sv[2]; f32x4 v[2][4];
#pragma unroll
        for (int q = 0; q < 2; ++q) { sv[q] = SEL[(size_t)rows[q] * 16 + (lane & 15)];
#pragma unroll
            for (int jj = 0; jj < 4; ++jj) v[q][jj] = ld_row4(XB + (size_t)rows[q] * DM + 4 * lane + 256 * jj); }
        unsigned mask[2]; float gt[2][4]; const unsigned char* yp[2][4];
#pragma unroll
        for (int q = 0; q < 2; ++q) { const int b = rows[q] >> 13; mask[q] = (unsigned)(__ballot(sv[q] >= 0) & 0xffffull);
#pragma unroll
            for (int k = 0; k < 4; ++k) { gt[q][k] = 0.f; yp[q][k] = YS + 4 * lane;
                if (mask[q]) { const int e = __builtin_ctz(mask[q]); mask[q] &= mask[q] - 1u; const int r = __builtin_amdgcn_readlane(sv[q], e); const size_t slot = (size_t)((e * NB + b) * CAP + r); gt[q][k] = GATE[slot] * (1.f / 64.f); yp[q][k] = YS + slot * DM + 4 * lane; } } }
        unsigned y[2][4][4];
#pragma unroll
        for (int q = 0; q < 2; ++q)
#pragma unroll
            for (int k = 0; k < 4; ++k)
#pragma unroll
                for (int jj = 0; jj < 4; ++jj) y[q][k][jj] = *(const unsigned*)(yp[q][k] + 256 * jj);
#pragma unroll
        for (int q = 0; q < 2; ++q) { if (q == 1 && !two) break; const int row = rows[q], b = row >> 13;
#pragma unroll
            for (int k = 0; k < 4; ++k)
#pragma unroll
                for (int jj = 0; jj < 4; ++jj) { const f32x2 lo = __builtin_amdgcn_cvt_pk_f32_fp8((int)y[q][k][jj], false), hi = __builtin_amdgcn_cvt_pk_f32_fp8((int)y[q][k][jj], true);
                    v[q][jj][0] += gt[q][k] * lo[0]; v[q][jj][1] += gt[q][k] * lo[1]; v[q][jj][2] += gt[q][k] * hi[0]; v[q][jj][3] += gt[q][k] * hi[1]; }
            unsigned mk = mask[q];
            while (mk) { const int e = __builtin_ctz(mk); mk &= mk - 1u; const int r = __builtin_amdgcn_readlane(sv[q], e); const size_t slot = (size_t)((e * NB + b) * CAP + r); const float g1 = GATE[slot] * (1.f / 64.f); const unsigned char* yr = YS + slot * DM + 4 * lane;
#pragma unroll
                for (int jj = 0; jj < 4; ++jj) { const int yy = *(const int*)(yr + 256 * jj); const f32x2 lo = __builtin_amdgcn_cvt_pk_f32_fp8(yy, false), hi = __builtin_amdgcn_cvt_pk_f32_fp8(yy, true);
                    v[q][jj][0] += g1 * lo[0]; v[q][jj][1] += g1 * lo[1]; v[q][jj][2] += g1 * hi[0]; v[q][jj][3] += g1 * hi[1]; } }
            bf16* xr = XB + (size_t)row * DM + 4 * lane;
#pragma unroll
            for (int jj = 0; jj < 4; ++jj) { if (XOUT) *(f32x4*)(XOUT + (size_t)row * DM + 4 * lane + 256 * jj) = v[q][jj]; else { u32x2 o; o.x = cvt_pk_bf16(v[q][jj][0], v[q][jj][1]); o.y = cvt_pk_bf16(v[q][jj][2], v[q][jj][3]); *(u32x2*)(xr + 256 * jj) = o; } }
            if (nmode >= 0) row_norm_tail(v[q], gn, HN, nmode, Wt, OUT16, row, lane);
        }
    }
    __syncthreads();
}
__device__ __forceinline__ void moe_convert_phase(LAS unsigned char* lds, const float* WG, const float* WU, const float* WDN, bf16* WGU, bf16* WD, unsigned* ctr, volatile LAS unsigned* slot, int tid, int wave, int lane) {
    LAS float* scr = (LAS float*)lds;
    constexpr int NGU = 16 * 16 * 4, NDN = 16 * 32 * 2;
    auto src_of = [&](int ch, int& ldw) -> const float* {
        if (ch < 2 * NGU) { const int kind = ch / NGU, r = ch % NGU, e = r >> 6, q = r & 63; ldw = 2048; return (kind == 0 ? WG : WU) + (size_t)e * 1024 * 2048 + (size_t)((q >> 2) * 64 + (tid >> 7)) * 2048 + (q & 3) * 512 + 4 * (tid & 127); }
        const int r = ch - 2 * NGU, e = r >> 6, q = r & 63; ldw = 1024; return WDN + (size_t)e * 2048 * 1024 + (size_t)((q >> 1) * 64 + (tid >> 7)) * 1024 + (q & 1) * 512 + 4 * (tid & 127); };
    f32x4 rv[16];
    int ch = wq_next(ctr, slot, tid);
    if (ch < 2 * NGU + NDN) { int ldw; const float* wp = src_of(ch, ldw);
#pragma unroll
        for (int i = 0; i < 16; ++i) rv[i] = *(const f32x4*)(wp + (size_t)(4 * i) * ldw); }
    while (ch < 2 * NGU + NDN) {
        bf16* WT; int Kd, k0, n0, kind;
        if (ch < 2 * NGU) { kind = ch / NGU; const int r = ch % NGU, e = r >> 6, q = r & 63; k0 = (q >> 2) * 64; n0 = (q & 3) * 512; WT = WGU + (size_t)e * 4096 * 512; Kd = 1024; }
        else { kind = 2; const int r = ch - 2 * NGU, e = r >> 6, q = r & 63; k0 = (q >> 1) * 64; n0 = (q & 1) * 512; WT = WD + (size_t)e * 1024 * 1024; Kd = 2048; }
#pragma unroll
        for (int i = 0; i < 16; ++i) { LAS float* d = scr + (4 * i + (tid >> 7)) * 513 + 4 * (tid & 127); d[0] = rv[i][0]; d[1] = rv[i][1]; d[2] = rv[i][2]; d[3] = rv[i][3]; }
        const int chn = wq_next(ctr, slot, tid);
        if (chn < 2 * NGU + NDN) { int ldw; const float* wp = src_of(chn, ldw);
#pragma unroll
            for (int i = 0; i < 16; ++i) rv[i] = *(const f32x4*)(wp + (size_t)(4 * i) * ldw); }
        const int c = tid & 7;
#pragma unroll
        for (int j = 0; j < 8; ++j) { const int n = (tid >> 3) + 64 * j; const LAS float* sp = scr + (8 * c) * 513 + n;
            const int ng = n0 + n, nd = kind == 2 ? ng : ((ng >> 7) * 256 + (kind == 1 ? 128 : 0) + (ng & 127));
            { u32x2 o; o.x = pk_fp8x4(sp[0 * 513] * 64.f, sp[1 * 513] * 64.f, sp[2 * 513] * 64.f, sp[3 * 513] * 64.f); o.y = pk_fp8x4(sp[4 * 513] * 64.f, sp[5 * 513] * 64.f, sp[6 * 513] * 64.f, sp[7 * 513] * 64.f);
                *(u32x2*)((unsigned char*)WT + (size_t)nd * Kd + k0 + 8 * c) = o; } }
        lds_barrier();
        ch = chn;
    }
    __syncthreads();
}
typedef float f32x4_t __attribute__((ext_vector_type(4)));
__device__ __forceinline__ f32x4 mfma16(bf16x8 a, bf16x8 b, f32x4 c) { return __builtin_amdgcn_mfma_f32_16x16x32_bf16(a, b, c, 0, 0, 0); }
__device__ __forceinline__ f32x4 tile_abT(const LAS unsigned char* Ai, const LAS unsigned char* Bi, int ti, int tj, int lane) {
    f32x4 acc = (f32x4){0.f, 0.f, 0.f, 0.f}; bf16x8 a[4], b[4];
#pragma unroll
    for (int ks = 0; ks < 4; ++ks) { a[ks] = *(const LAS bf16x8*)(Ai + (16 * ti + (lane & 15)) * 272 + (32 * ks + 8 * (lane >> 4)) * 2);
        b[ks] = *(const LAS bf16x8*)(Bi + (16 * tj + (lane & 15)) * 272 + (32 * ks + 8 * (lane >> 4)) * 2); }
#pragma unroll
    for (int ks = 0; ks < 4; ++ks) acc = mfma16(a[ks], b[ks], acc);
    return acc;
}
__device__ __forceinline__ size_t fm128(int s, int c, int row, int col) { return ((((size_t)s * 128 + c) * 16 + (row >> 4) * 4 + (col >> 5)) * 512) + ((col >> 3) & 3) * 128 + (row & 15) * 8 + (col & 7); }
__device__ __forceinline__ size_t fmkd(int s, int c, int d, int i) { return ((((size_t)s * 128 + c) * 16 + (d >> 4) * 2 + (i >> 5)) * 512) + ((i >> 3) & 3) * 128 + (d & 15) * 8 + (i & 7); }
__device__ __forceinline__ size_t fmat(int s, int c, int i, int j) { return ((((size_t)s * 128 + c) * 8 + (i >> 4) * 2 + (j >> 5)) * 512) + ((j >> 3) & 3) * 128 + (i & 15) * 8 + (j & 7); }
__device__ __forceinline__ int spos(int dir, int sr) { return dir == 0 ? sr : SEQ - 1 - sr; }

struct HpreIn { u32x4 za, zb; u32x4 qa, qb; };
__device__ __forceinline__ void hpre_load(HpreIn& in, int unit, int tid, const bf16* QS, const bf16* ZF, const bf16* ZB) {
    const int c = unit & 127, s = unit >> 7, h = s & 3, b = (s >> 2) & 3, dir = s >> 4, r = tid >> 3, cg = (tid & 7) * 16;
    const size_t trow = (size_t)b * SEQ + spos(dir, c * 64 + r);
    const bf16* zp = (dir == 0 ? ZF : ZB) + trow * 512 + h * 128 + cg;
    in.za = *(const u32x4*)zp; in.zb = *(const u32x4*)(zp + 8);
    in.qa = *(const u32x4*)(QS + trow * 512 + h * 128 + cg); in.qb = *(const u32x4*)(QS + trow * 512 + h * 128 + cg + 8);
}
__device__ __forceinline__ void hpre_phase(LAS unsigned char* lds, unsigned* ctr, volatile LAS unsigned* slot, int tid, const float* LB  , const bf16* QS, const bf16* ZF, const bf16* ZB,
                                           bf16* QD, bf16* KDT, bf16* AT, float* DEC) {
    const int lane = tid & 63, wave = tid >> 6;
    LAS float* LF = (LAS float*)lds; LAS unsigned char* QT = lds + 33792; LAS unsigned char* KT = lds + 51200; LAS unsigned char* KD = lds + 68608;
    LAS float* SEG = (LAS float*)(lds + 86016); LAS float* ER = (LAS float*)(lds + 88064); LAS float* EB = (LAS float*)(lds + 88576);
    const int r = tid >> 3, cg = (tid & 7) * 16;
    int unit = wq_next(ctr, slot, tid);
    HpreIn nx; if (unit < 4096) hpre_load(nx, unit, tid, QS, ZF, ZB);
    while (unit < 4096) {
        const int c = unit & 127, s = unit >> 7, h = s & 3, b = (s >> 2) & 3, dir = s >> 4;
        const size_t srow = (size_t)dir * T + (size_t)b * SEQ + c * 64 + r;
        const HpreIn in = nx;
        float q[16], k[16];
        {   const float* lbp = LB + dir * 512 + h * 128 + cg;
            q[0] = bflo(in.qa.x); q[1] = bfhi(in.qa.x); q[2] = bflo(in.qa.y); q[3] = bfhi(in.qa.y); q[4] = bflo(in.qa.z); q[5] = bfhi(in.qa.z); q[6] = bflo(in.qa.w); q[7] = bfhi(in.qa.w);
            q[8] = bflo(in.qb.x); q[9] = bfhi(in.qb.x); q[10] = bflo(in.qb.y); q[11] = bfhi(in.qb.y); q[12] = bflo(in.qb.z); q[13] = bfhi(in.qb.z); q[14] = bflo(in.qb.w); q[15] = bfhi(in.qb.w);
#pragma unroll
            for (int e4 = 0; e4 < 4; ++e4) { const u32x4 zz = e4 < 2 ? in.za : in.zb; const unsigned z01 = (e4 & 1) ? zz.z : zz.x, z23 = (e4 & 1) ? zz.w : zz.y;
                const f32x4 z = (f32x4){bflo(z01), bfhi(z01), bflo(z23), bfhi(z23)}, lb = *(const f32x4*)(lbp + 4 * e4); f32x4 lf;
#pragma unroll
                for (int e = 0; e < 4; ++e) { const float sg = fast_rcp(1.f + fast_exp(-z[e])); const float f = lb[e] + (1.f - lb[e]) * sg; lf[e] = fast_log(f); k[4 * e4 + e] = 1.f - f; }
                *(LAS f32x4*)(LF + r * 132 + cg + 4 * e4) = lf; }
        }
        const int nunit = wq_next(ctr, slot, tid);
        if (nunit < 4096) hpre_load(nx, nunit, tid, QS, ZF, ZB);
        lds_barrier();
        {   const int seg = tid >> 7, col = tid & 127; float run = 0.f, lv[16];
#pragma unroll
            for (int i = 0; i < 16; ++i) lv[i] = LF[(16 * seg + i) * 132 + col];
#pragma unroll
            for (int i = 0; i < 16; ++i) { run += lv[i]; lv[i] = run; }
            SEG[seg * 128 + col] = run;
            lds_barrier();
            float off = 0.f; for (int s2 = 0; s2 < seg; ++s2) off += SEG[s2 * 128 + col];
#pragma unroll
            for (int i = 0; i < 16; ++i) LF[(16 * seg + i) * 132 + col] = lv[i] + off;
            if (seg == 0) { const float b31 = SEG[col] + SEG[128 + col], b63 = b31 + SEG[256 + col] + SEG[384 + col];
                ER[col] = fast_exp(b31); EB[col] = fast_exp(b63 - b31); DEC[((size_t)s * 128 + c) * 128 + col] = fast_exp(b63); }
        }
        lds_barrier();
        {   float qt[16], kt[16], qd[16], kd[16];
#pragma unroll
            for (int e = 0; e < 16; ++e) { const float bb = LF[r * 132 + cg + e], rr = LF[31 * 132 + cg + e];
                qt[e] = q[e] * fast_exp(fminf(bb - rr, 60.f)); kt[e] = k[e] * fast_exp(fminf(rr - bb, 60.f)); qd[e] = qt[e] * ER[cg + e]; kd[e] = kt[e] * EB[cg + e]; }
            u32x4 o0, o1;
            o0.x = cvt_pk_bf16(qt[0], qt[1]); o0.y = cvt_pk_bf16(qt[2], qt[3]); o0.z = cvt_pk_bf16(qt[4], qt[5]); o0.w = cvt_pk_bf16(qt[6], qt[7]);
            o1.x = cvt_pk_bf16(qt[8], qt[9]); o1.y = cvt_pk_bf16(qt[10], qt[11]); o1.z = cvt_pk_bf16(qt[12], qt[13]); o1.w = cvt_pk_bf16(qt[14], qt[15]);
            *(LAS u32x4*)(QT + r * 272 + cg * 2) = o0; *(LAS u32x4*)(QT + r * 272 + cg * 2 + 16) = o1;
            o0.x = cvt_pk_bf16(kt[0], kt[1]); o0.y = cvt_pk_bf16(kt[2], kt[3]); o0.z = cvt_pk_bf16(kt[4], kt[5]); o0.w = cvt_pk_bf16(kt[6], kt[7]);
            o1.x = cvt_pk_bf16(kt[8], kt[9]); o1.y = cvt_pk_bf16(kt[10], kt[11]); o1.z = cvt_pk_bf16(kt[12], kt[13]); o1.w = cvt_pk_bf16(kt[14], kt[15]);
            *(LAS u32x4*)(KT + r * 272 + cg * 2) = o0; *(LAS u32x4*)(KT + r * 272 + cg * 2 + 16) = o1;
            o0.x = cvt_pk_bf16(kd[0], kd[1]); o0.y = cvt_pk_bf16(kd[2], kd[3]); o0.z = cvt_pk_bf16(kd[4], kd[5]); o0.w = cvt_pk_bf16(kd[6], kd[7]);
            o1.x = cvt_pk_bf16(kd[8], kd[9]); o1.y = cvt_pk_bf16(kd[10], kd[11]); o1.z = cvt_pk_bf16(kd[12], kd[13]); o1.w = cvt_pk_bf16(kd[14], kd[15]);
            *(LAS u32x4*)(KD + r * 272 + cg * 2) = o0; *(LAS u32x4*)(KD + r * 272 + cg * 2 + 16) = o1;
            o0.x = cvt_pk_bf16(qd[0], qd[1]); o0.y = cvt_pk_bf16(qd[2], qd[3]); o0.z = cvt_pk_bf16(qd[4], qd[5]); o0.w = cvt_pk_bf16(qd[6], qd[7]);
            o1.x = cvt_pk_bf16(qd[8], qd[9]); o1.y = cvt_pk_bf16(qd[10], qd[11]); o1.z = cvt_pk_bf16(qd[12], qd[13]); o1.w = cvt_pk_bf16(qd[14], qd[15]);
            *(u32x4*)(QD + fm128(s, c, r, cg)) = o0; *(u32x4*)(QD + fm128(s, c, r, cg + 8)) = o1;
        }
        lds_barrier();
        {   const int d = tid >> 2, i0 = (tid & 3) * 16; unsigned short v[16];
#pragma unroll
            for (int e = 0; e < 16; ++e) v[e] = *(const LAS unsigned short*)(KD + (i0 + e) * 272 + d * 2);
            u32x4 o0, o1;
            o0.x = v[0] | ((unsigned)v[1] << 16); o0.y = v[2] | ((unsigned)v[3] << 16); o0.z = v[4] | ((unsigned)v[5] << 16); o0.w = v[6] | ((unsigned)v[7] << 16);
            o1.x = v[8] | ((unsigned)v[9] << 16); o1.y = v[10] | ((unsigned)v[11] << 16); o1.z = v[12] | ((unsigned)v[13] << 16); o1.w = v[14] | ((unsigned)v[15] << 16);
            *(u32x4*)(KDT + fmkd(s, c, d, i0)) = o0; *(u32x4*)(KDT + fmkd(s, c, d, i0 + 8)) = o1; }
#pragma unroll
        for (int tt = 0; tt < 2; ++tt) { const int idx = 2 * wave + tt, ti = idx >> 2, tj = idx & 3;
            f32x4 p = (f32x4){0.f, 0.f, 0.f, 0.f};
            if (tj <= ti) p = tile_abT(QT, KT, ti, tj, lane);
            const int j = 16 * tj + (lane & 15);
#pragma unroll
            for (int e = 0; e < 4; ++e) { const int i = 16 * ti + 4 * (lane >> 4) + e; AT[fmat(s, c, i, j)] = f2bf(j <= i ? p[e] : 0.f); } }
        lds_barrier();
        unit = nunit;
    }
}

struct GpreIn { u32x4 k0, k1, q0, q1, v0, v1; float g, bt; };
__device__ __forceinline__ void gpre_load(GpreIn& in, int unit, int tid, const bf16* GQ, const bf16* GK, const bf16* GV, const float* GG, const float* GBT) {
    const int c = unit & 127, s = unit >> 7, h = s & 3, b = (s >> 2) & 3, dir = s >> 4, r = tid >> 3, cg = (tid & 7) * 16;
    const size_t go = ((size_t)b * SEQ + spos(dir, c * 64 + r)) * 512 + h * 128 + cg;
    in.k0 = *(const u32x4*)(GK + go); in.k1 = *(const u32x4*)(GK + go + 8); in.q0 = *(const u32x4*)(GQ + go); in.q1 = *(const u32x4*)(GQ + go + 8); in.v0 = *(const u32x4*)(GV + go); in.v1 = *(const u32x4*)(GV + go + 8);
    const size_t tr2 = (size_t)b * SEQ + spos(dir, c * 64 + (tid & 63)); in.g = GG[tr2 * 8 + dir * 4 + h]; in.bt = GBT[tr2 * 8 + dir * 4 + h];
}
template <int VAR>
__device__ __forceinline__ void gpre_phase(LAS unsigned char* lds, int bx, int G, int tid, const bf16* GQ, const bf16* GK, const bf16* GV, const float* GG, const float* GBT,
                                           bf16* QD, bf16* KDT, bf16* VAL, bf16* KC, bf16* AT, float* DEC) {
    const int lane = tid & 63, wave = __builtin_amdgcn_readfirstlane(tid >> 6), l15 = lane & 15, l4 = lane >> 4;
    LAS float* FK = (LAS float*)(lds + 141824);
    LAS unsigned char* KL = lds; LAS unsigned char* QL = lds + 17408; LAS unsigned char* VL = lds + 34816; LAS float* AM = (LAS float*)(lds + 52224);
    LAS float* GAM = (LAS float*)(lds + 69632); LAS float* BETA = (LAS float*)(lds + 69888);
    LAS unsigned char* AMB = lds + 70144; LAS unsigned char* XTB = lds + 79360; LAS unsigned char* DB = lds + 116224; LAS unsigned char* RB = lds + 121344;
    GpreIn nx; if (bx < 4096) gpre_load(nx, bx, tid, GQ, GK, GV, GG, GBT);
    for (int unit = bx; unit < 4096; unit += G) {
        const int c = unit & 127, s = unit >> 7, h = s & 3, b = (s >> 2) & 3, dir = s >> 4;
        {   const int r = tid >> 3, cg = (tid & 7) * 16;
            *(LAS u32x4*)(KL + r * 272 + cg * 2) = nx.k0; *(LAS u32x4*)(KL + r * 272 + cg * 2 + 16) = nx.k1;
            *(LAS u32x4*)(QL + r * 272 + cg * 2) = nx.q0; *(LAS u32x4*)(QL + r * 272 + cg * 2 + 16) = nx.q1;
            *(LAS u32x4*)(VL + r * 272 + cg * 2) = nx.v0; *(LAS u32x4*)(VL + r * 272 + cg * 2 + 16) = nx.v1;
            if (tid < 64) { float gsum = nx.g; BETA[tid] = nx.bt;
#pragma unroll
                for (int o = 1; o < 64; o <<= 1) { const float t = shfl_up_f(gsum, o, lane); if (lane >= o) gsum += t; }
                GAM[tid] = gsum; }
            for (int i = tid; i < (36864 + 5120 + 20480) / 16; i += 512) ((LAS u32x4*)XTB)[i] = (u32x4){0u, 0u, 0u, 0u};
        }
        if (unit + G < 4096) gpre_load(nx, unit + G, tid, GQ, GK, GV, GG, GBT);
        lds_barrier();
        const float gl = GAM[63];
#pragma unroll
        for (int tt = 0; tt < 2; ++tt) { if (VAR & 2) break; const int idx = 2 * wave + tt, ti = idx >> 2, tj = idx & 3;
            f32x4 kk = (f32x4){0.f, 0.f, 0.f, 0.f}, qk = kk;
            if (tj <= ti) { kk = tile_abT(KL, KL, ti, tj, lane); qk = tile_abT(QL, KL, ti, tj, lane); }
            const int j = 16 * tj + l15; const float gj = GAM[j];
            const f32x4 gi4 = *(const LAS f32x4*)(GAM + 16 * ti + 4 * l4), bi4 = *(const LAS f32x4*)(BETA + 16 * ti + 4 * l4);
#pragma unroll
            for (int e = 0; e < 4; ++e) { const int i = 16 * ti + 4 * l4 + e; const float dcy = fast_exp(fminf(gi4[e] - gj, 0.f));
                const float av = (j < i) ? bi4[e] * kk[e] * dcy : 0.f;
                AM[i * 68 + j] = av; *(LAS unsigned short*)(AMB + i * 144 + j * 2) = f2bf(av);
                if (!(VAR & 4)) AT[fmat(s, c, i, j)] = f2bf(j <= i ? qk[e] * dcy : 0.f); } }
        lds_barrier();
        if (tid < 64) { const int bb = tid >> 4, cc = tid & 15; float x[16];
            const LAS float* Ab = AM + (16 * bb) * 68 + 16 * bb;
            f32x4 P[16][4];
#pragma unroll
            for (int ii = 1; ii <= 12; ++ii)
#pragma unroll
                for (int q = 0; q < (ii + 3) / 4; ++q) P[ii][q] = *(const LAS f32x4*)(Ab + ii * 68 + 4 * q);
            __builtin_amdgcn_sched_barrier(0);
#pragma unroll
            for (int ii = 0; ii <= 8; ++ii) { float acc = (ii == cc) ? 1.f : 0.f;
#pragma unroll
                for (int jj = 0; jj < ii; ++jj) acc -= P[ii][jj >> 2][jj & 3] * x[jj];
                x[ii] = acc; }
            __builtin_amdgcn_sched_barrier(0);
#pragma unroll
            for (int ii = 13; ii <= 15; ++ii)
#pragma unroll
                for (int q = 0; q < 4; ++q) P[ii][q] = *(const LAS f32x4*)(Ab + ii * 68 + 4 * q);
            __builtin_amdgcn_sched_barrier(0);
#pragma unroll
            for (int ii = 9; ii < 16; ++ii) { float acc = (ii == cc) ? 1.f : 0.f;
#pragma unroll
                for (int jj = 0; jj < ii; ++jj) acc -= P[ii][jj >> 2][jj & 3] * x[jj];
                x[ii] = acc; }
#pragma unroll
            for (int ii = 0; ii < 16; ++ii) *(LAS unsigned short*)(DB + (16 * bb + ii) * 80 + cc * 2) = f2bf(x[ii]);
        } else if (tid < 128) { const int i = tid - 64; FK[i] = BETA[i] * fast_exp(GAM[i]);
        } else if (tid >= 256) {
            const int t2 = tid - 256;
            {   const int r = t2 >> 2, cg = (t2 & 3) * 32; const float eg = fast_exp(GAM[r]); const size_t srow = (size_t)dir * T + (size_t)b * SEQ + c * 64 + r;
#pragma unroll
                for (int e8 = 0; e8 < 4; ++e8) { const u32x4 qv = *(const LAS u32x4*)(QL + r * 272 + (cg + 8 * e8) * 2); u32x4 o;
                    o.x = cvt_pk_bf16(bflo(qv.x) * eg, bfhi(qv.x) * eg); o.y = cvt_pk_bf16(bflo(qv.y) * eg, bfhi(qv.y) * eg); o.z = cvt_pk_bf16(bflo(qv.z) * eg, bfhi(qv.z) * eg); o.w = cvt_pk_bf16(bflo(qv.w) * eg, bfhi(qv.w) * eg);
                    *(u32x4*)(QD + fm128(s, c, r, cg + 8 * e8)) = o; } }
#pragma unroll
            for (int rep = 0; rep < 2; ++rep) { const int it = t2 + 256 * rep, d = it >> 2, i0 = (it & 3) * 16; float v[16];
#pragma unroll
                for (int e = 0; e < 16; ++e) v[e] = bf2f(*(const LAS unsigned short*)(KL + (i0 + e) * 272 + d * 2)) * fast_exp(gl - GAM[i0 + e]);
                u32x4 o0, o1;
                o0.x = cvt_pk_bf16(v[0], v[1]); o0.y = cvt_pk_bf16(v[2], v[3]); o0.z = cvt_pk_bf16(v[4], v[5]); o0.w = cvt_pk_bf16(v[6], v[7]);
                o1.x = cvt_pk_bf16(v[8], v[9]); o1.y = cvt_pk_bf16(v[10], v[11]); o1.z = cvt_pk_bf16(v[12], v[13]); o1.w = cvt_pk_bf16(v[14], v[15]);
                *(u32x4*)(KDT + fmkd(s, c, d, i0)) = o0; *(u32x4*)(KDT + fmkd(s, c, d, i0 + 8)) = o1; }
            if (t2 < 128) DEC[((size_t)s * 128 + c) * 128 + t2] = fast_exp(gl);
        }
        lds_barrier();
        for (int bb = 0; bb < 4; ++bb) {
            const int nks = bb == 3 ? 2 : 1;
#pragma unroll
            for (int tt = 0; tt < 2; ++tt) { const int ct = 2 * wave + tt, col = 16 * ct + l15; f32x4 acc = (f32x4){0.f, 0.f, 0.f, 0.f};
                if (bb > 0) for (int ks = 0; ks < nks; ++ks) { const bf16x8 af = *(const LAS bf16x8*)(AMB + (16 * bb + l15) * 144 + (32 * ks + 8 * l4) * 2);
                    const bf16x8 bf = *(const LAS bf16x8*)(XTB + col * 144 + (32 * ks + 8 * l4) * 2); acc = mfma16(af, bf, acc); }
                const bool isk = wave >= 4;
                const LAS unsigned char* src = isk ? KL : VL; float r[4];
                const f32x4 f4 = *(const LAS f32x4*)((isk ? FK : BETA) + 16 * bb + 4 * l4);
                unsigned short sv[4];
#pragma unroll
                for (int e = 0; e < 4; ++e) sv[e] = *(const LAS unsigned short*)(src + (16 * bb + 4 * l4 + e) * 272 + (col & 127) * 2);
#pragma unroll
                for (int e = 0; e < 4; ++e) r[e] = bf2f(sv[e]) * f4[e] - acc[e];
                u32x2 w; w.x = cvt_pk_bf16(r[0], r[1]); w.y = cvt_pk_bf16(r[2], r[3]);
                *(LAS u32x2*)(RB + col * 80 + (4 * l4) * 2) = w; }
            lds_barrier();
#pragma unroll
            for (int tt = 0; tt < 2; ++tt) { const int ct = 2 * wave + tt, col = 16 * ct + l15;
                const bf16x8 af = *(const LAS bf16x8*)(DB + (16 * bb + l15) * 80 + (8 * l4) * 2), bf = *(const LAS bf16x8*)(RB + col * 80 + (8 * l4) * 2);
                const f32x4 x = mfma16(af, bf, (f32x4){0.f, 0.f, 0.f, 0.f});
                u32x2 w; w.x = cvt_pk_bf16(x[0], x[1]); w.y = cvt_pk_bf16(x[2], x[3]);
                *(LAS u32x2*)(XTB + col * 144 + (16 * bb + 4 * l4) * 2) = w;
                if (col >= 128) {
#pragma unroll
                    for (int e = 0; e < 4; ++e) KC[fm128(s, c, 16 * bb + 4 * l4 + e, col & 127)] = f2bf(x[e]); }
                else { bf16* dst = VAL + ((size_t)dir * T + (size_t)b * SEQ + c * 64 + 16 * bb + 4 * l4) * 512 + h * 128 + col;
#pragma unroll
                    for (int e = 0; e < 4; ++e) dst[(size_t)e * 512] = f2bf(x[e]); } }
            lds_barrier();
        }
    }
}

struct ScanOpsA { bf16x8 qd[4], kc[4], at[2]; u32x2 val[4]; };
struct ScanOpsB { bf16x8 kd[2][2]; f32x4 dec[2]; };
#define SCAN_LD4(dst, voff, base, imm) asm volatile("global_load_dwordx4 %0, %1, %2 offset:" #imm : "=&v"(dst) : "v"(voff), "s"(base) : "memory")
#define SCAN_LD2(dst, voff, base, imm) asm volatile("global_load_dwordx2 %0, %1, %2 offset:" #imm : "=&v"(dst) : "v"(voff), "s"(base) : "memory")
template <bool GDN>
__device__ __forceinline__ void scan_load_a(ScanOpsA& o, int c, size_t rb, int s, int h, int sl, int ti, int l15, int l4, const bf16* QD, const bf16* VAL, const bf16* KC, const bf16* AT) {
    const unsigned vfrag = (unsigned)(16 * l4 + l15) * 16u;
    const size_t cb = ((size_t)s * 128 + c) * 8192 + (size_t)(ti * 4) * 512;
    const bf16* bq = QD + cb; const bf16* bk = KC + cb; const bf16* ba = AT + ((size_t)s * 128 + c) * 4096 + (size_t)(ti * 2) * 512;
    SCAN_LD4(o.qd[0], vfrag, bq, 0); SCAN_LD4(o.qd[1], vfrag, bq, 1024); SCAN_LD4(o.qd[2], vfrag, bq, 2048); SCAN_LD4(o.qd[3], vfrag, bq, 3072);
    if (GDN) { SCAN_LD4(o.kc[0], vfrag, bk, 0); SCAN_LD4(o.kc[1], vfrag, bk, 1024); SCAN_LD4(o.kc[2], vfrag, bk, 2048); SCAN_LD4(o.kc[3], vfrag, bk, 3072); }
    SCAN_LD4(o.at[0], vfrag, ba, 0); SCAN_LD4(o.at[1], vfrag, ba, 1024);
    const int sr0 = c * 64 + 16 * ti;
    if (GDN || !(s >> 4)) { const size_t r0 = GDN ? rb + sr0 : (size_t)((s >> 2) & 3) * SEQ + sr0;
        const bf16* bv = VAL + r0 * 512 + h * 128 + 64 * sl; const unsigned vv = (unsigned)(4 * l4) * 1024u + (unsigned)l15 * 8u;
        SCAN_LD2(o.val[0], vv, bv, 0); SCAN_LD2(o.val[1], vv, bv, 1024); SCAN_LD2(o.val[2], vv, bv, 2048); SCAN_LD2(o.val[3], vv, bv, 3072); }
    else { const size_t r0 = (size_t)((s >> 2) & 3) * SEQ + (SEQ - 1 - (sr0 + 15));
        const bf16* bv = VAL + r0 * 512 + h * 128 + 64 * sl; const unsigned vv = (unsigned)(15 - 4 * l4) * 1024u + (unsigned)l15 * 8u;
        SCAN_LD2(o.val[0], vv, bv, 0); SCAN_LD2(o.val[1], vv, bv, -1024); SCAN_LD2(o.val[2], vv, bv, -2048); SCAN_LD2(o.val[3], vv, bv, -3072); }
}
__device__ __forceinline__ void scan_load_b(ScanOpsB& o, int c, int s, int w4, int l15, int l4, const bf16* KDT, const float* DEC) {
    const unsigned vfrag = (unsigned)(16 * l4 + l15) * 16u, vdec = (unsigned)l4 * 16u;
    const bf16* bk = KDT + ((size_t)s * 128 + c) * 8192 + (size_t)(2 * w4 * 2) * 512; const float* bd = DEC + ((size_t)s * 128 + c) * 128 + 16 * (2 * w4);
    SCAN_LD4(o.kd[0][0], vfrag, bk, 0); SCAN_LD4(o.kd[0][1], vfrag, bk, 1024); SCAN_LD4(o.kd[1][0], vfrag, bk, 2048); SCAN_LD4(o.kd[1][1], vfrag, bk, 3072);
    SCAN_LD4(o.dec[0], vdec, bd, 0); SCAN_LD4(o.dec[1], vdec, bd, 64);
}
#define SCAN_WAIT(n) asm volatile("s_waitcnt vmcnt(" #n ")" ::: "memory")
template <bool GDN>
__device__ __forceinline__ void scan_touch_a(ScanOpsA& o) {
#pragma unroll
    for (int i = 0; i < 4; ++i) { asm volatile("" : "+v"(o.qd[i])); if (GDN) asm volatile("" : "+v"(o.kc[i])); asm volatile("" : "+v"(o.val[i])); }
    asm volatile("" : "+v"(o.at[0])); asm volatile("" : "+v"(o.at[1]));
}
__device__ __forceinline__ void scan_touch_b(ScanOpsB& o) {
#pragma unroll
    for (int i = 0; i < 2; ++i) { asm volatile("" : "+v"(o.kd[i][0])); asm volatile("" : "+v"(o.kd[i][1])); asm volatile("" : "+v"(o.dec[i])); }
}
template <bool GDN>
__device__ __forceinline__ void scan_unit(LAS unsigned char* lds, int unit, int tid, const bf16* QD, const bf16* KDT, const bf16* VAL, const bf16* KC, const bf16* AT, const float* DEC, bf16* OS) {
    const int sl = unit & 1, s = unit >> 1, h = s & 3, b = (s >> 2) & 3, dir = s >> 4, lane = tid & 63, wave = __builtin_amdgcn_readfirstlane(tid >> 6);
    const int l15 = lane & 15, l4 = lane >> 4;
    LAS unsigned char* ST = lds; LAS unsigned char* VN = lds + 34816;
    for (int i = tid; i < (34816 + 9216) / 4; i += 512) ((LAS unsigned*)lds)[i] = 0u;
    lds_barrier();
    const size_t rb = (size_t)dir * T + (size_t)b * SEQ;
    int cur = 0;
    constexpr int NST = GDN ? 3 : 4, PD = NST - 1;
    if (wave < 4) {
        const int ti = wave;
        ScanOpsA st[NST];
#pragma unroll
        for (int i = 0; i < PD; ++i) scan_load_a<GDN>(st[i], i, rb, s, h, sl, ti, l15, l4, QD, VAL, KC, AT);
#pragma nounroll
        for (int c0 = 0; c0 < NCH; c0 += NST) {
#pragma unroll
            for (int u = 0; u < NST; ++u) { const int c = c0 + u; if (c >= NCH) break;
                if (c + PD < NCH) { scan_load_a<GDN>(st[(u + PD) % NST], c + PD, rb, s, h, sl, ti, l15, l4, QD, VAL, KC, AT);
                    if (c < PD) { if (GDN) SCAN_WAIT(28); else SCAN_WAIT(30); }
                    else { if (GDN) SCAN_WAIT(36); else SCAN_WAIT(42); } }
                else SCAN_WAIT(0);
                scan_touch_a<GDN>(st[u]);
                const ScanOpsA& op = st[u];
                const LAS unsigned char* STc = ST + cur * 17408;
                f32x4 o[4]; bf16x8 sB[4], sBn[4];
#pragma unroll
                for (int ks = 0; ks < 4; ++ks) sB[ks] = *(const LAS bf16x8*)(STc + l15 * 272 + (32 * ks + 8 * l4) * 2);
#pragma unroll
                for (int ct = 0; ct < 4; ++ct) {
                    if (ct + 1 < 4) {
#pragma unroll
                        for (int ks = 0; ks < 4; ++ks) sBn[ks] = *(const LAS bf16x8*)(STc + (16 * (ct + 1) + l15) * 272 + (32 * ks + 8 * l4) * 2); }
                    f32x4 vn;
#pragma unroll
                    for (int e = 0; e < 4; ++e) { const unsigned w2 = ct < 2 ? op.val[e].x : op.val[e].y; vn[e] = (ct & 1) ? bfhi(w2) : bflo(w2); }
                    if (GDN) { f32x4 ks_ = (f32x4){0.f, 0.f, 0.f, 0.f};
#pragma unroll
                        for (int ks = 0; ks < 4; ++ks) ks_ = mfma16(op.kc[ks], sB[ks], ks_);
                        vn = vn - ks_; }
                    {   u32x2 w; w.x = cvt_pk_bf16(vn[0], vn[1]); w.y = cvt_pk_bf16(vn[2], vn[3]);
                        *(LAS u32x2*)(VN + (16 * ct + l15) * 144 + (16 * ti + 4 * l4) * 2) = w; }
                    f32x4 oc = (f32x4){0.f, 0.f, 0.f, 0.f};
#pragma unroll
                    for (int ks = 0; ks < 4; ++ks) oc = mfma16(op.qd[ks], sB[ks], oc);
                    o[ct] = oc;
#pragma unroll
                    for (int ks = 0; ks < 4; ++ks) sB[ks] = sBn[ks]; }
                lds_barrier();
                {   bf16x8 vbA[4][2];
#pragma unroll
                    for (int ct = 0; ct < 4; ++ct)
#pragma unroll
                        for (int ks = 0; ks < 2; ++ks) vbA[ct][ks] = *(const LAS bf16x8*)(VN + (16 * ct + l15) * 144 + (32 * ks + 8 * l4) * 2);
#pragma unroll
                    for (int ct = 0; ct < 4; ++ct) { f32x4 oc = o[ct];
#pragma unroll
                        for (int ks = 0; ks < 2; ++ks) oc = mfma16(op.at[ks], vbA[ct][ks], oc);
                        o[ct] = oc; } }
#pragma unroll
                for (int e = 0; e < 4; ++e) { u32x2 w; w.x = cvt_pk_bf16(o[0][e], o[1][e]); w.y = cvt_pk_bf16(o[2][e], o[3][e]); *(u32x2*)(OS + (rb + c * 64 + 16 * ti + 4 * l4 + e) * 512 + h * 128 + 64 * sl + 4 * l15) = w; }
                lds_barrier();
                cur ^= 1;
            }
        }
    } else {
        const int w4 = wave - 4;
        f32x4 Sacc[2][4];
#pragma unroll
        for (int dd = 0; dd < 2; ++dd)
#pragma unroll
            for (int t2 = 0; t2 < 4; ++t2) Sacc[dd][t2] = (f32x4){0.f, 0.f, 0.f, 0.f};
        ScanOpsB st[NST];
#pragma unroll
        for (int i = 0; i < PD; ++i) scan_load_b(st[i], i, s, w4, l15, l4, KDT, DEC);
#pragma nounroll
        for (int c0 = 0; c0 < NCH; c0 += NST) {
#pragma unroll
            for (int u = 0; u < NST; ++u) { const int c = c0 + u; if (c >= NCH) break;
                if (c + PD < NCH) { scan_load_b(st[(u + PD) % NST], c + PD, s, w4, l15, l4, KDT, DEC); if (GDN) SCAN_WAIT(12); else SCAN_WAIT(18); }
                else SCAN_WAIT(0);
                scan_touch_b(st[u]);
                const ScanOpsB& op = st[u];
                lds_barrier();
                LAS unsigned char* STn = ST + (cur ^ 1) * 17408;
                bf16x8 vbB[4][2];
#pragma unroll
                for (int t2 = 0; t2 < 4; ++t2)
#pragma unroll
                    for (int ks = 0; ks < 2; ++ks) vbB[t2][ks] = *(const LAS bf16x8*)(VN + (16 * t2 + l15) * 144 + (32 * ks + 8 * l4) * 2);
#pragma unroll
                for (int t2 = 0; t2 < 4; ++t2) {
#pragma unroll
                    for (int dd = 0; dd < 2; ++dd) { f32x4 a = Sacc[dd][t2] * op.dec[dd];
#pragma unroll
                        for (int ks = 0; ks < 2; ++ks) a = mfma16(op.kd[dd][ks], vbB[t2][ks], a);
                        Sacc[dd][t2] = a;
                        u32x2 w; w.x = cvt_pk_bf16(a[0], a[1]); w.y = cvt_pk_bf16(a[2], a[3]);
                        *(LAS u32x2*)(STn + (16 * t2 + l15) * 272 + (16 * (2 * w4 + dd) + 4 * l4) * 2) = w; } }
                lds_barrier();
                cur ^= 1;
            }
        }
    }
}
__device__ __forceinline__ void oprep_unit(LAS unsigned char* lds, int unit, int tid, const bf16* PO, const float* AB, const float* convw  , const float* alog  , const float* dtb  ,
                                           const float* qg, const float* kg, bf16* AQ, bf16* AK, bf16* AVT, bf16* GQ, bf16* GK, bf16* GV, float* GG, float* GBT) {
    const int h = unit & 3, tb = (unit >> 2) & 127, b = unit >> 9, lane = tid & 63, wave = tid >> 6;
    const u32x4 zero4 = (u32x4){0u, 0u, 0u, 0u};
    {   u32x4 va[7], vb[6];
#pragma unroll
        for (int i = 0; i < 7; ++i) { const int p = tid + 512 * i, pc = p & 15, rr = p >> 4, t = rr >= 136 ? 2 : (rr >= 68 ? 1 : 0), row = rr - t * 68; const int pos = tb * 64 - 2 + row;
            const int posc = pos < 0 ? 0 : (pos >= SEQ ? SEQ - 1 : pos);
            va[i] = zero4; if (i < 6 || tid < 192) va[i] = *(const u32x4*)(PO + ((size_t)b * SEQ + posc) * ODD_N + 1536 + t * 512 + h * 128 + pc * 8);
            if (pos < 0 || pos >= SEQ) va[i] = zero4; }
#pragma unroll
        for (int i = 0; i < 6; ++i) { const int p2 = tid + 512 * i, t = p2 >> 10, row = (p2 & 1023) >> 4, pc = p2 & 15;
            vb[i] = *(const u32x4*)(PO + ((size_t)b * SEQ + tb * 64 + row) * ODD_N + t * 512 + h * 128 + pc * 8); }
#pragma unroll
        for (int i = 0; i < 7; ++i) { const int p = tid + 512 * i, pc = p & 15, rr = p >> 4, t = rr >= 136 ? 2 : (rr >= 68 ? 1 : 0), row = rr - t * 68;
            if (i < 6 || tid < 192) *(LAS u32x4*)(lds + t * 18496 + row * 272 + pc * 16) = va[i]; }
#pragma unroll
        for (int i = 0; i < 6; ++i) { const int p2 = tid + 512 * i, t = p2 >> 10, row = (p2 & 1023) >> 4, pc = p2 & 15;
            *(LAS u32x4*)(lds + 55488 + t * 17408 + row * 272 + pc * 16) = vb[i]; }
    }
    float w[3][5][2];
#pragma unroll
    for (int t3 = 0; t3 < 3; ++t3)
#pragma unroll
        for (int tap = 0; tap < 5; ++tap) { const f32x2 ww = *(const f32x2*)(convw + tap * 1536 + t3 * 512 + h * 128 + 2 * lane); w[t3][tap][0] = ww[0]; w[t3][tap][1] = ww[1]; }
    const f32x2 qg2 = *(const f32x2*)(qg + 2 * (lane & 31)), kg2 = *(const f32x2*)(kg + 2 * (lane & 31));
    const float qgs = 0.125f * LOG2E;
    float gav = 0.f, gbv = 0.f;
    if (tid < 128) { const size_t grow = (size_t)b * SEQ + tb * 64 + (tid >> 1); const int dir = tid & 1; gav = AB[grow * 16 + dir * 4 + h] + dtb[dir * 4 + h]; gbv = AB[grow * 16 + 8 + dir * 4 + h]; }
    lds_barrier();
    {
        float xw[3][5][2];
        unsigned xrow[3][12], qrow[8], krow[8];
#pragma unroll
        for (int t3 = 0; t3 < 3; ++t3)
#pragma unroll
            for (int rr = 0; rr < 12; ++rr) xrow[t3][rr] = *(const LAS unsigned*)(lds + t3 * 18496 + (wave * 8 + rr) * 272 + 4 * lane);
#pragma unroll
        for (int tt = 0; tt < 8; ++tt) { qrow[tt] = *(const LAS unsigned*)(lds + 55488 + (wave * 8 + tt) * 272 + 4 * lane); krow[tt] = *(const LAS unsigned*)(lds + 72896 + (wave * 8 + tt) * 272 + 4 * lane); }
#pragma unroll
        for (int t3 = 0; t3 < 3; ++t3)
#pragma unroll
            for (int tap = 1; tap < 5; ++tap) { const unsigned xv = xrow[t3][tap - 1]; xw[t3][tap][0] = bflo(xv); xw[t3][tap][1] = bfhi(xv); }
#pragma unroll
        for (int tt = 0; tt < 8; ++tt) { const int tok = wave * 8 + tt, pos = tb * 64 + tok; const size_t row = (size_t)b * SEQ + pos;
            float a[3][2];
#pragma unroll
            for (int t3 = 0; t3 < 3; ++t3) {
#pragma unroll
                for (int tap = 0; tap < 4; ++tap) { xw[t3][tap][0] = xw[t3][tap + 1][0]; xw[t3][tap][1] = xw[t3][tap + 1][1]; }
                const unsigned xv = xrow[t3][tt + 4]; xw[t3][4][0] = bflo(xv); xw[t3][4][1] = bfhi(xv);
                float a0 = 0.f, a1 = 0.f;
#pragma unroll
                for (int tap = 0; tap < 5; ++tap) { a0 += xw[t3][tap][0] * w[t3][tap][0]; a1 += xw[t3][tap][1] * w[t3][tap][1]; }
                a[t3][0] = siluf_(a0); a[t3][1] = siluf_(a1); }
            const float sq = wave_sum(a[0][0] * a[0][0] + a[0][1] * a[0][1]), sk = wave_sum(a[1][0] * a[1][0] + a[1][1] * a[1][1]);
            const float rq = __builtin_amdgcn_rsqf(sq + EPS) * 0.08838834764831845f, rk = __builtin_amdgcn_rsqf(sk + EPS);
            const size_t oo = row * 512 + h * 128 + 2 * lane;
            *(unsigned*)(GQ + oo) = cvt_pk_bf16(a[0][0] * rq, a[0][1] * rq); *(unsigned*)(GK + oo) = cvt_pk_bf16(a[1][0] * rk, a[1][1] * rk); *(unsigned*)(GV + oo) = cvt_pk_bf16(a[2][0], a[2][1]);
            const unsigned qv = qrow[tt], kv = krow[tt];
            const float q0 = bflo(qv), q1 = bfhi(qv), k0 = bflo(kv), k1 = bfhi(kv);
            const float rqa = __builtin_amdgcn_rsqf(half_sum(q0 * q0 + q1 * q1, lane) * (1.f / 64) + EPS) * qgs, rka = __builtin_amdgcn_rsqf(half_sum(k0 * k0 + k1 * k1, lane) * (1.f / 64) + EPS);
            const size_t oa = (((size_t)(b * 4 + h) * 2 + (lane >> 5)) * SEQ + pos) * 64 + 2 * (lane & 31);
            *(unsigned*)(AQ + oa) = cvt_pk_bf16(q0 * rqa * qg2[0], q1 * rqa * qg2[1]); *(unsigned*)(AK + oa) = cvt_pk_bf16(k0 * rka * kg2[0], k1 * rka * kg2[1]); }
    }
    if (tid < 128) { const size_t grow = (size_t)b * SEQ + tb * 64 + (tid >> 1); const int dir = tid & 1;
        const float sp = gav > 20.f ? gav : fast_log(1.f + fast_exp(gav));
        GG[grow * 8 + dir * 4 + h] = -fast_exp(alog[dir * 4 + h]) * sp; GBT[grow * 8 + dir * 4 + h] = sigmoidf_(gbv); }
    {   const int dv = tid >> 2, t0 = (tid & 3) * 16; unsigned short v[16];
#pragma unroll
        for (int e = 0; e < 16; ++e) { v[e] = *(const LAS unsigned short*)(lds + 90304 + (t0 + e) * 272 + dv * 2);
#ifdef EMU3
            v[e] = f2bf(q8(bf2f(v[e]), 16.f));
#endif
        }
        u32x4 o0, o1;
        o0.x = v[0] | ((unsigned)v[1] << 16); o0.y = v[2] | ((unsigned)v[3] << 16); o0.z = v[8] | ((unsigned)v[9] << 16); o0.w = v[10] | ((unsigned)v[11] << 16);
        o1.x = v[4] | ((unsigned)v[5] << 16); o1.y = v[6] | ((unsigned)v[7] << 16); o1.z = v[12] | ((unsigned)v[13] << 16); o1.w = v[14] | ((unsigned)v[15] << 16);
        bf16* d = AVT + ((size_t)(b * 4 + h) * 128 + dv) * SEQ + tb * 64 + t0; *(u32x4*)d = o0; *(u32x4*)(d + 8) = o1; }
    lds_barrier();
}

__device__ __forceinline__ int t5_bucket_dev(int rel) { const int n = rel < 0 ? -rel : rel; int lg;
    if (n < 8) lg = n; else if (n < 12) lg = 8; else if (n < 16) lg = 9; else if (n < 23) lg = 10; else if (n < 32) lg = 11; else if (n < 46) lg = 12; else if (n < 64) lg = 13; else if (n < 91) lg = 14; else lg = 15;
    return (rel > 0 ? 16 : 0) + lg; }
__device__ __forceinline__ f32x16 mfma32(bf16x8 a, bf16x8 b, f32x16 c) { return __builtin_amdgcn_mfma_f32_32x32x16_bf16(a, b, c, 0, 0, 0); }
__device__ __forceinline__ float wave_max(float v) {
    v = fmaxf(v, __int_as_float(__builtin_amdgcn_update_dpp(0, __float_as_int(v), 0xB1, 0xf, 0xf, true)));
    v = fmaxf(v, __int_as_float(__builtin_amdgcn_update_dpp(0, __float_as_int(v), 0x4E, 0xf, 0xf, true)));
    v = fmaxf(v, __int_as_float(__builtin_amdgcn_update_dpp(0, __float_as_int(v), 0x141, 0xf, 0xf, true)));
    v = fmaxf(v, __int_as_float(__builtin_amdgcn_update_dpp(0, __float_as_int(v), 0x140, 0xf, 0xf, true)));
    const int vi = __float_as_int(v);
    return fmaxf(fmaxf(__int_as_float(__builtin_amdgcn_readlane(vi, 0)), __int_as_float(__builtin_amdgcn_readlane(vi, 16))), fmaxf(__int_as_float(__builtin_amdgcn_readlane(vi, 32)), __int_as_float(__builtin_amdgcn_readlane(vi, 48))));
}
constexpr int AT_K = 2112 + 1984  , KSLOT = 64 * 128, AT_V = AT_K + 2 * KSLOT, VSLOT = 128 * 128, AT_Q = AT_V + 3 * VSLOT;
#ifndef ALT_GRP
#define ALT_GRP 1
#endif
template <int GRP, int VAR>
__device__ __forceinline__ void attn_tiles(LAS unsigned char* lds, f32x16 (&oacc)[4], float& lsum, const bf16* Kbase, const bf16* Vbase, int tid, int l31, int hh, int q0, int qrow, float cL, float cR, float mfix, const LAS unsigned char* QL) {
    constexpr int NT = SEQ / 64;
    const LAS float* BT = (const LAS float*)lds;
    const int lane = tid & 63, wv = __builtin_amdgcn_readfirstlane(tid >> 6);
    const int drow = lane >> 3, dpc = (lane & 7) ^ (((wv & 1) << 2) + (drow >> 1));
    const unsigned xs = (unsigned)(((l31 >> 1) & 7) << 4);
#define AT_DMA(kt_) do { const int t_ = (kt_); \
        __builtin_amdgcn_global_load_lds((const unsigned*)(Kbase + (size_t)(t_ * 64 + 8 * wv + drow) * 64 + dpc * 8), (LAS unsigned*)(lds + AT_K + (t_ & 1) * KSLOT + wv * 1024), 16, 0, 0); \
        _Pragma("unroll") for (int i_ = 0; i_ < 2; ++i_) \
            __builtin_amdgcn_global_load_lds((const unsigned*)(Vbase + (size_t)(8 * (wv + 8 * i_) + drow) * SEQ + t_ * 64 + dpc * 8), (LAS unsigned*)(lds + AT_V + (t_ % 3) * VSLOT + (wv + 8 * i_) * 1024), 16, 0, 0); } while (0)
    AT_DMA(0);
    unsigned pfw[16];
#pragma unroll
    for (int i = 0; i < 16; ++i) pfw[i] = 0u;
    f32x2 ps2 = (f32x2){0.f, 0.f};
    for (int kt = 0; kt < NT; ++kt) {
        const LAS unsigned char* KL = lds + AT_K + (kt & 1) * KSLOT; const LAS unsigned char* VP = lds + AT_V + ((kt + 2) % 3) * VSLOT;
        __syncthreads();
        if (kt + 1 < NT) AT_DMA(kt + 1);
        const int k0 = kt * 64;
        const bool farL = (k0 + 63 - q0 <= -128), farR = (k0 - (q0 + 31) >= 128);
        const float cinit = farL ? cL : (farR ? cR : -mfix);
        f32x16 sa[2];
#pragma unroll
        for (int sb = 0; sb < 2; ++sb)
#pragma unroll
            for (int r = 0; r < 16; ++r) sa[sb][r] = cinit;
#pragma unroll
        for (int ks = 0; ks < 4; ++ks) { const bf16x8 qq = *(const LAS bf16x8*)(QL + 32 * ks);
#pragma unroll
            for (int sb = 0; sb < 2; ++sb) { const bf16x8 ka = *(const LAS bf16x8*)(KL + (32 * sb + l31) * 128 + (((2 * ks + hh) << 4) ^ xs)); sa[sb] = mfma32(ka, qq, sa[sb]); } }
        if (!(farL || farR)) { const LAS float* bp = BT + (k0 - qrow + 256 + 4 * hh);
#pragma unroll
            for (int sb = 0; sb < 2; ++sb)
#pragma unroll
                for (int r = 0; r < 16; ++r) sa[sb][r] += bp[32 * sb + (r & 3) + 8 * (r >> 2)]; }
        __builtin_amdgcn_sched_barrier(0);
        bf16x8 vf[8];
#pragma unroll
        for (int i = 0; i < 4; ++i) vf[i] = *(const LAS bf16x8*)(VP + (32 * i + l31) * 128 + (((0 + hh) << 4) ^ xs));
        unsigned pnw[16];
#pragma unroll
        for (int idx = 0; idx < 16; ++idx) { const int st = idx >> 2, d = idx & 3;
            if (idx + 4 < 16) { const int i2 = idx + 4, st2 = i2 >> 2, d2 = i2 & 3; vf[i2 & 7] = *(const LAS bf16x8*)(VP + (32 * d2 + l31) * 128 + (((2 * st2 + hh) << 4) ^ xs)); }
            const bf16x8 pb = __builtin_bit_cast(bf16x8, (u32x4){pfw[4 * st], pfw[4 * st + 1], pfw[4 * st + 2], pfw[4 * st + 3]});
            oacc[d] = mfma32(vf[idx & 7], pb, oacc[d]);
            asm volatile("" : "+v"(oacc[d]));
            {   const int sb = idx >> 3, r = 2 * (idx & 7); float s0 = sa[sb][r], s1 = sa[sb][r + 1];
                asm volatile("" : "+v"(s0), "+v"(s1));
                const float p0 = __builtin_amdgcn_exp2f(s0), p1 = __builtin_amdgcn_exp2f(s1); ps2 += (f32x2){p0, p1}; unsigned w = cvt_pk_bf16(p0, p1);
                asm volatile("" : "+v"(w), "+v"(ps2));
                pnw[idx] = w; }
            __builtin_amdgcn_sched_barrier(0);
        }
#pragma unroll
        for (int i = 0; i < 16; ++i) pfw[i] = pnw[i];
    }
    lsum += ps2[0] + ps2[1];
    {   const LAS unsigned char* VP = lds + AT_V + ((NT - 1) % 3) * VSLOT;
#pragma unroll
        for (int st = 0; st < 4; ++st) { const bf16x8 pb = __builtin_bit_cast(bf16x8, (u32x4){pfw[4 * st], pfw[4 * st + 1], pfw[4 * st + 2], pfw[4 * st + 3]});
#pragma unroll
            for (int d = 0; d < 4; ++d) oacc[d] = mfma32(*(const LAS bf16x8*)(VP + (32 * d + l31) * 128 + (((2 * st + hh) << 4) ^ xs)), pb, oacc[d]); } }
#undef AT_DMA
}
template <int VAR>
__device__ __forceinline__ void attn_unit(LAS unsigned char* lds, int unit, int tid, const bf16* AQ, const bf16* AK, const bf16* AVT, const float* relb, const float* qg, const float* kg, bf16* AO) {
    const int qb = unit & 31, bhc = unit >> 5, bh = bhc >> 1, h = bh & 3, lane = tid & 63, wave = tid >> 6, l31 = lane & 31, hh = lane >> 5;
    LAS float* BT = (LAS float*)lds;
    const int q0 = qb * 256 + wave * 32, qrow = q0 + l31;
    int rel = tid - 256; rel = rel < -128 ? -128 : (rel > 128 ? 128 : rel);
    const float btv = relb[t5_bucket_dev(rel) * 4 + h], qgv = qg[lane], kgv = kg[lane], rbv = lane < 32 ? relb[lane * 4 + h] : 0.f, cLv = relb[15 * 4 + h], cRv = relb[31 * 4 + h];
    bf16x8 qv[4];
#pragma unroll
    for (int ks = 0; ks < 4; ++ks) qv[ks] = *(const bf16x8*)(AQ + ((size_t)bhc * SEQ + qrow) * 64 + 16 * ks + 8 * hh);
    BT[tid] = btv * LOG2E;
    for (int i = tid; i < VSLOT / 4; i += 512) ((LAS unsigned*)(lds + AT_V + 2 * VSLOT))[i] = 0u;
    const float gqm = wave_max(fabsf(qgv)), gkm = wave_max(fabsf(kgv)), bmx = wave_max(fabsf(rbv));
    const float mfix = 8.f * LOG2E * gqm * gkm * 1.03f + bmx * LOG2E;
    LAS unsigned char* QL = lds + AT_Q + (wave * 32 + l31) * 144 + 16 * hh;
#pragma unroll
    for (int ks = 0; ks < 4; ++ks) *(LAS bf16x8*)(QL + 32 * ks) = qv[ks];
    f32x16 oacc[4];
#pragma unroll
    for (int d = 0; d < 4; ++d)
#pragma unroll
        for (int r = 0; r < 16; ++r) oacc[d][r] = 0.f;
    float lsum = 0.f;
    const bf16* Kbase = AK + (size_t)bhc * SEQ * 64; const bf16* Vbase = AVT + (size_t)bh * 128 * SEQ;
    const float cL = cLv * LOG2E - mfix, cR = cRv * LOG2E - mfix;
    if (wave < 4) attn_tiles<0, VAR>(lds, oacc, lsum, Kbase, Vbase, tid, l31, hh, q0, qrow, cL, cR, mfix, QL);
    else attn_tiles<1, VAR>(lds, oacc, lsum, Kbase, Vbase, tid, l31, hh, q0, qrow, cL, cR, mfix, QL);
    const float ltot = lsum + shfl_xor32(lsum, lane), inv = 1.f / ltot;
    bf16* orow = AO + ((size_t)bhc * SEQ + qrow) * 128;
#pragma unroll
    for (int d = 0; d < 4; ++d)
#pragma unroll
        for (int g4 = 0; g4 < 4; ++g4) { u32x2 w; w.x = cvt_pk_bf16(oacc[d][4 * g4] * inv, oacc[d][4 * g4 + 1] * inv); w.y = cvt_pk_bf16(oacc[d][4 * g4 + 2] * inv, oacc[d][4 * g4 + 3] * inv); *(u32x2*)(orow + 32 * d + 8 * g4 + 4 * hh) = w; }
    __syncthreads();
}

__device__ __forceinline__ void acomb_phase(const bf16* AO, const float* clam  , const float* outg  , float lam_init, bf16* MIX, int gw, int NGW, int lane) {
    const float s01 = wave_sum(clam[lane] * clam[64 + lane]), s23 = wave_sum(clam[128 + lane] * clam[192 + lane]);
    const float lam_full = expf(s01) - expf(s23) + lam_init;
    const float g0 = outg[2 * lane] * (1.f - lam_init), g1 = outg[2 * lane + 1] * (1.f - lam_init);
#pragma unroll 2
    for (int row = gw; row < T; row += NGW) { const int b = row >> 13, pos = row & (SEQ - 1);
        unsigned o0[4], o1[4];
#pragma unroll
        for (int h = 0; h < 4; ++h) { o0[h] = *(const unsigned*)(AO + (((size_t)(b * 4 + h) * 2 + 0) * SEQ + pos) * 128 + 2 * lane); o1[h] = *(const unsigned*)(AO + (((size_t)(b * 4 + h) * 2 + 1) * SEQ + pos) * 128 + 2 * lane); }
#pragma unroll
        for (int h = 0; h < 4; ++h) { const float a0 = bflo(o0[h]) - lam_full * bflo(o1[h]), a1 = bfhi(o0[h]) - lam_full * bfhi(o1[h]);
            const float rs = __builtin_amdgcn_rsqf(wave_sum(a0 * a0 + a1 * a1) * (1.f / 128) + EPS);
            *(unsigned*)(MIX + (size_t)row * DM + h * 128 + 2 * lane) = cvt_pk_bf16(QM(a0 * rs * g0), QM(a1 * rs * g1)); } }
}
__device__ __forceinline__ void scomb_phase(const bf16* OS, const float* outg, const bf16* gate, int gstride, int goff, bool gate_silu, bf16* MIX, int coff, int gw, int NGW, int lane) {
    const float g0 = outg[2 * lane], g1 = outg[2 * lane + 1];
#pragma unroll 2
    for (int row = gw; row < T; row += NGW) { const int b = row >> 13, pos = row & (SEQ - 1);
        unsigned of[4], ob[4]; unsigned gv[4];
#pragma unroll
        for (int h = 0; h < 4; ++h) { of[h] = *(const unsigned*)(OS + ((size_t)b * SEQ + pos) * 512 + h * 128 + 2 * lane); ob[h] = *(const unsigned*)(OS + ((size_t)T + (size_t)b * SEQ + (SEQ - 1 - pos)) * 512 + h * 128 + 2 * lane);
            gv[h] = *(const unsigned*)(gate + (size_t)row * gstride + goff + h * 128 + 2 * lane); }
#pragma unroll
        for (int h = 0; h < 4; ++h) { const float a0 = bflo(of[h]) + bflo(ob[h]), a1 = bfhi(of[h]) + bfhi(ob[h]);
            const float rs = __builtin_amdgcn_rsqf(wave_sum(a0 * a0 + a1 * a1) * (1.f / 128) + EPS);
            float t0 = bflo(gv[h]), t1 = bfhi(gv[h]);
            if (gate_silu) { t0 = siluf_(t0); t1 = siluf_(t1); }
            *(unsigned*)(MIX + (size_t)row * DM + coff + h * 128 + 2 * lane) = cvt_pk_bf16(QM(a0 * rs * g0 * t0), QM(a1 * rs * g1 * t1)); } }
}
#ifndef REP_ATTN
#define REP_ATTN 1
#endif
#ifndef REP_SCAN
#define REP_SCAN 1
#endif
#ifndef REP_SCANO
#define REP_SCANO REP_SCAN
#endif
#ifndef NCONV_FIRST
#define NCONV_FIRST 32
#endif
#ifndef REP_CONV
#define REP_CONV 1
#endif
#ifndef REP_PRE
#define REP_PRE 1
#endif
#ifndef REP_MISC
#define REP_MISC 1
#endif
#ifndef REP_MOEG
#define REP_MOEG 1
#endif
#ifndef REP_NORM
#define REP_NORM 1
#endif
#ifndef REP_X1
#define REP_X1 1
#endif
#ifndef REP_X2
#define REP_X2 1
#endif
#ifndef DUP_GEMM
#define DUP_GEMM 0
#endif
#ifdef EMU2
#define QS_IN ((EMU2 & 2) ? 64.f : 0.f)
#define QS_OUT ((EMU2 & 1) ? 64.f : 0.f)
#else
#define QS_IN 0.f
#define QS_OUT 0.f
#endif
#ifndef PHMASK
#define PHMASK 0xffffffffu
#endif
#define PH(n) ((PHMASK >> (n)) & 1u)
#define WEI ((bf16*)(ws + WS_WEI))
#define WOI ((bf16*)(ws + WS_WOI))
#define WEO ((bf16*)(ws + WS_WEO))
#define WOO ((bf16*)(ws + WS_WOO))
#define WGL ((bf16*)(ws + WS_WGL))
#define LBT ((float*)(ws + WS_LB))
#define KTAB ((float*)(ws + WS_KTAB))
#define TW ((bf16*)(ws + WS_TW))
#define SV ((bf16*)(ws + WS_SV))
#define WGU ((bf16*)(ws + WS_WGU))
#define WD ((bf16*)(ws + WS_WD))
#define HN ((bf16*)(ws + WS_HN))
#define MIX ((bf16*)(ws + WS_MIX))
#define QD ((bf16*)(ws + WS_R + R_QD))
#define KDT ((bf16*)(ws + WS_R + R_KDT))
#define VAL ((bf16*)(ws + WS_R + R_VAL))
#define KC ((bf16*)(ws + WS_R + R_KC))
#define AT ((bf16*)(ws + WS_R + R_AT))
#define DEC ((float*)(ws + WS_R + R_DEC))
#define OS ((bf16*)(ws + WS_R + R_OS))
#define QS ((bf16*)(ws + WS_R + R_QS))
#define ZF ((bf16*)(ws + WS_R + R_ZF))
#define ZB ((bf16*)(ws + WS_R + R_ZB))
#define VI ((bf16*)(ws + WS_R + R_VI))
#define GA ((bf16*)(ws + WS_R + R_GA))
#define UP ((bf16*)(ws + WS_R + R_UP))
#define EB ((float*)(ws + WS_R + R_EB))
#define YG ((bf16*)(ws + WS_R + R_YG))
#define PO ((bf16*)(ws + WS_R + R_PO))
#define AB ((float*)(ws + WS_R + R_AB))
#define AQ ((bf16*)(ws + WS_R + R_AQ))
#define AK ((bf16*)(ws + WS_R + R_AK))
#define AVT ((bf16*)(ws + WS_R + R_AVT))
#define AO ((bf16*)(ws + WS_R + R_AO))
#define GQ ((bf16*)(ws + WS_R + R_GQ))
#define GK ((bf16*)(ws + WS_R + R_GK))
#define GV ((bf16*)(ws + WS_R + R_GV))
#define GG ((float*)(ws + WS_R + R_GG))
#define GBT ((float*)(ws + WS_R + R_GB))
#define AFF ((float*)(ws + WS_R + R_AFF))
#define SEL ((int*)(ws + WS_R + R_SEL))
#define IDX ((int*)(ws + WS_R + R_IDX))
#define GATE ((float*)(ws + WS_R + R_GATE))
#define XG ((bf16*)(ws + WS_R + R_XG))
#define HN8 ((bf16*)(ws + WS_R + R_XG))
#define HID ((bf16*)(ws + WS_R + R_HID))
#define YS ((bf16*)(ws + WS_R + R_YS))
#define YS8 ((unsigned char*)(ws + WS_R + R_YS))
#define KIN(i) ((const float*)(const GAS float*)kp[i])
#define X ((float*)(GAS float*)kp[32])
#define XB ((bf16*)(ws + WS_XB))

__global__ void __launch_bounds__(512, 2) hybrid_fwd(Args A) {
    extern __shared__ __attribute__((aligned(16))) unsigned char lds_raw[];
    LAS unsigned char* lds = (LAS unsigned char*)lds_raw;
    const int G0 = gridDim.x, bx0 = blockIdx.x;
    typedef const float* const __attribute__((address_space(4))) * KArgP;
    KArgP kp0 = (KArgP)__builtin_amdgcn_kernarg_segment_ptr();
    unsigned char* ws0 = (unsigned char*)kp0[33];
    int tid, lane, wave, gw, G, bx, NGW; GAS unsigned char* wsg; KArgP kp;
#define ws ((unsigned char*)wsg)
#define RELAUNDER() do { G = G0; asm volatile("" : "+s"(G)); bx = bx0; asm volatile("" : "+s"(bx)); NGW = G * 8; tid = threadIdx.x; asm volatile("" : "+v"(tid)); wsg = (GAS unsigned char*)ws0; asm volatile("" : "+s"(wsg)); kp = kp0; asm volatile("" : "+s"(kp)); lane = tid & 63; wave = __builtin_amdgcn_readfirstlane(tid >> 6); gw = bx * 8 + wave; } while (0)
    const int tid0 = threadIdx.x;
    volatile LAS unsigned* MISC = (volatile LAS unsigned*)(lds + MISC_OFF);
    for (int u = tid0; u < (LDS_BYTES - RING_BYTES) / 4; u += 512) ((LAS unsigned*)(lds + RING_BYTES))[u] = 0u;
    __syncthreads();
    XcdBarrier bar = xcd_barrier_post((unsigned*)(ws0 + WS_CTL), MISC + 8);
#define GRID_BAR() do { xcd_barrier_t<false>(bar); RELAUNDER(); } while (0)
#define GRID_BAR_FIRST() do { xcd_barrier_t<true>(bar); RELAUNDER(); } while (0)
    RELAUNDER();
    if (PH(23)) {
        LAS float* scr = (LAS float*)(lds + wave * 16384);
        constexpr int IE = 16 * 96, IO = 16 * 112, IP = 16 * 32, IG = 8 * 16;
        constexpr int NIT = 2 * (IE + IO + IP + IP + IG);
        for (int it = gw; it < NIT; it += NGW) { int r = it; const int j = r & 1; r >>= 1;
            if (r < IE) { tr_item(KIN(I_EVWIN) + (size_t)j * DM * EVEN_IN, EVEN_IN, WEI + (size_t)j * EVEN_IN * DM, DM, (r / 96) * 64, (r % 96) * 32, (r % 96) * 32, scr, lane, QS_IN); continue; } r -= IE;
            if (r < IO) { const int nd = (r % 112) * 32, nsrc = nd < 3072 ? nd : nd + 16; tr_item(KIN(I_ODWIN) + (size_t)j * DM * ODD_IN, ODD_IN, WOI + (size_t)j * ODD_N * DM, DM, (r / 112) * 64, nsrc, nd, scr, lane, QS_IN); continue; } r -= IO;
            if (r < IP) { tr_item(KIN(I_EVWOUT) + (size_t)j * DM * DM, DM, WEO + (size_t)j * DM * DM, DM, (r / 32) * 64, (r % 32) * 32, (r % 32) * 32, scr, lane, QS_OUT); continue; } r -= IP;
            if (r < IP) { tr_item(KIN(I_ODWOUT) + (size_t)j * DM * DM, DM, WOO + (size_t)j * DM * DM, DM, (r / 32) * 64, (r % 32) * 32, (r % 32) * 32, scr, lane, QS_OUT); continue; } r -= IP;
            tr_item(KIN(I_S5GW) + (size_t)j * 512 * 512, 512, WGL + (size_t)j * 512 * 512, 512, (r / 16) * 64, (r % 16) * 32, (r % 16) * 32, scr, lane); }
        if (bx == 0) { for (int i = tid; i < 1024; i += 512) { const float l0 = KIN(I_ALB)[i], l1 = KIN(I_ALB)[1024 + i]; const float m = fmaxf(l0, l1), e0 = expf(l0 - m), e1 = expf(l1 - m);
                LBT[i] = 0.f; LBT[1024 + i] = e1 / (e0 + e1); } }
        LAS float* kscr = scr;
        {   Args AL; for (int i_ = I_S5LRE; i_ <= I_S5D; ++i_) AL.in[i_] = KIN(i_);
            for (int it = gw; it < 2 * 2 * 32 * 64; it += NGW) s5_ktab_item(AL, KTAB, it, kscr, lane); }
    }
    GRID_BAR_FIRST();
    for (int rep_ = 0; rep_ < REP_X2; ++rep_) if (PH(24)) { Args AL; for (int i_ = I_S5LRE; i_ <= I_S5D; ++i_) AL.in[i_] = KIN(i_); for (int u = bx; u < 4096; u += G) s5_tw_unit(AL, KTAB, TW, u, tid, (LAS float*)lds); }
    for (int rep_ = 0; rep_ < REP_X2; ++rep_) if (PH(24)) { Args AL; for (int i_ = I_S5LRE; i_ <= I_S5D; ++i_) AL.in[i_] = KIN(i_); for (int u = bx; u < 256; u += G) s5_sv_unit(AL, SV, u, tid); }

    for (int layer = 0; layer < 4; ++layer) {
        const int j = layer >> 1; const bool even = (layer & 1) == 0;
        if (layer == 0) { norm_phase(lds, KIN(I_X), KIN(I_MIXN), HN, 0, nullptr, 0, nullptr, bx, G, tid); GRID_BAR(); }
        if (even) {
            if (PH(1)) {   pg8::Gemm g{HN, WEI + (size_t)j * EVEN_IN * DM, DM, DM, DM}; pg8::Sched S; S.init(128, 12, G, bx, 20, 0);
                EpiEvenIn E{QS, ZF, ZB, VI, GA, UP}; pg8::gemm_phase(lds, g, S, E, tid); }
#if (DUP_GEMM >> 0) & 1
            __syncthreads();
            if (PH(1)) {   pg8::Gemm g{HN, WEI + (size_t)j * EVEN_IN * DM, DM, DM, DM}; pg8::Sched S; S.init(128, 12, G, bx, 20, 0);
                EpiEvenIn E{QS, ZF, ZB, VI, GA, UP}; pg8::gemm_phase(lds, g, S, E, tid); }
#endif
            GRID_BAR();
            if (PH(3)) {   pg8::Gemm g{UP, SV + (size_t)j * 32 * 256 * 1024, 1024, 1280, 1024}; pg8::Sched S; S.init(64, 1, G, bx, 1, 1);
                EpiF32 E{EB, 256}; pg8::gemm_phase(lds, g, S, E, tid); }
            __syncthreads();
            if (PH(2)) hpre_phase(lds, (unsigned*)(ws + WS_CTL) + CW_Q + 64 * (12 + layer), MISC + 16, tid, LBT + j * 1024, QS, ZF, ZB, QD, KDT, AT, DEC);
#ifdef REP_HPRE
            if (PH(2)) hpre_phase(lds, (unsigned*)(ws + WS_CTL) + CW_Q + 64 * (16 + layer), MISC + 16, tid, LBT + j * 1024, QS, ZF, ZB, QD, KDT, AT, DEC);
#endif
#if (DUP_GEMM >> 1) & 1
            __syncthreads();
            if (PH(3)) {   pg8::Gemm g{UP, SV + (size_t)j * 32 * 256 * 1024, 1024, 1280, 1024}; pg8::Sched S; S.init(64, 1, G, bx, 1, 1);
                EpiF32 E{EB, 256}; pg8::gemm_phase(lds, g, S, E, tid); }
#endif
            GRID_BAR();
            if (!PH(4)) {} else if (bx < 64) { for (int rep_ = 0; rep_ < REP_SCAN; ++rep_) scan_unit<false>(lds, (bx & 7) * 8 + (bx >> 3), tid, QD, KDT, VI, KC, AT, DEC, OS); }
            else if (bx >= 128 && bx < 160) { Args AL; for (int i_ = I_S5LRE; i_ <= I_S5LS; ++i_) AL.in[i_] = KIN(i_); s5_carry(AL, j, EB, UP, (bx - 128) * 512 + tid); }
            __syncthreads();
            if (PH(17)) moe_convert_phase(lds, KIN(I_WGATE) + (size_t)layer * NE * DM * FF, KIN(I_WUP) + (size_t)layer * NE * DM * FF, KIN(I_WDOWN) + (size_t)layer * NE * FF * DM, WGU, WD, (unsigned*)(ws + WS_CTL) + CW_Q + 64 * (2 * layer), MISC + 16, tid, wave, lane);
            GRID_BAR();
            for (int rep_ = 0; rep_ < REP_X1; ++rep_) if (PH(5)) scomb_phase(OS, KIN(I_AOUTN) + j * 128, GA, 512, 0, false, MIX, 0, gw, NGW, lane);
            if (PH(6)) {   pg8::Gemm g{UP, TW + (size_t)j * 32 * 1024 * 1280, 1280, 1280, 1280}; pg8::Sched S; S.init(64, 4, G, bx, 1, 4);
                EpiS5Main E{YG}; pg8::gemm_phase(lds, g, S, E, tid); }
#if (DUP_GEMM >> 2) & 1
            __syncthreads();
            if (PH(6)) {   pg8::Gemm g{UP, TW + (size_t)j * 32 * 1024 * 1280, 1280, 1280, 1280}; pg8::Sched S; S.init(64, 4, G, bx, 1, 4);
                EpiS5Main E{YG}; pg8::gemm_phase(lds, g, S, E, tid); }
#endif
            GRID_BAR();
            if (PH(7)) {   pg8::Gemm g{YG, WGL + (size_t)j * 512 * 512, 512, 512, 512}; pg8::Sched S; S.init(128, 2, G, bx, 20, 0);
                EpiGlu E{YG, KIN(I_S5GB) + j * 512, MIX}; pg8::gemm_phase(lds, g, S, E, tid); }
#if (DUP_GEMM >> 3) & 1
            __syncthreads();
            if (PH(7)) {   pg8::Gemm g{YG, WGL + (size_t)j * 512 * 512, 512, 512, 512}; pg8::Sched S; S.init(128, 2, G, bx, 20, 0);
                EpiGlu E{YG, KIN(I_S5GB) + j * 512, MIX}; pg8::gemm_phase(lds, g, S, E, tid); }
#endif
            GRID_BAR();
        } else {
            if (PH(8)) {   pg8::Gemm g{HN, WOI + (size_t)j * ODD_N * DM, DM, DM, DM}; pg8::Sched S; S.init(128, 14, G, bx, 20, 0);
                EpiBf16 E{PO, ODD_N}; pg8::gemm_phase(lds, g, S, E, tid); }
#if (DUP_GEMM >> 4) & 1
            __syncthreads();
            if (PH(8)) {   pg8::Gemm g{HN, WOI + (size_t)j * ODD_N * DM, DM, DM, DM}; pg8::Sched S; S.init(128, 14, G, bx, 20, 0);
                EpiBf16 E{PO, ODD_N}; pg8::gemm_phase(lds, g, S, E, tid); }
#endif
            GRID_BAR();
            for (int rep_ = 0; rep_ < REP_MISC; ++rep_) if (PH(9)) for (int u = bx; u < 2048; u += G) oprep_unit(lds, u, tid, PO, AB, KIN(I_DCONV) + (size_t)j * 5 * 1536, KIN(I_DALOG) + j * 8, KIN(I_DDTB) + j * 8, KIN(I_CQN) + j * 64, KIN(I_CKN) + j * 64, AQ, AK, AVT, GQ, GK, GV, GG, GBT);
            GRID_BAR();
            if (PH(11)) gpre_phase<0>(lds, bx, G, tid, GQ, GK, GV, GG, GBT, QD, KDT, VAL, KC, AT, DEC);
#ifdef GPRE_VAR
            gpre_phase<GPRE_VAR>(lds, bx, G, tid, GQ, GK, GV, GG, GBT, QD, KDT, VAL, KC, AT, DEC);
#endif
            GRID_BAR();
            if (PH(12)) if (bx < 64) { for (int rep_ = 0; rep_ < REP_SCANO; ++rep_) scan_unit<true>(lds, (bx & 7) * 8 + (bx >> 3), tid, QD, KDT, VAL, KC, AT, DEC, OS); }
            if (PH(13)) for (;;) { const int u = wq_next_xcd((unsigned*)(ws + WS_CTL) + CW_Q + 64 * (24 + 8 * layer), (int)(xb_xcc_id() & 7u), 128, MISC + 16, tid); if (u < 0) break; attn_unit<0>(lds, u, tid, AQ, AK, AVT, KIN(I_RELB), KIN(I_CQN) + j * 64, KIN(I_CKN) + j * 64, AO); }
#if defined(REP_ATTN2)
            if (PH(13)) for (;;) { const int u = wq_next((unsigned*)(ws + WS_CTL) + CW_Q + 64 * (8 + layer), MISC + 16, tid); if (u >= 1024) break; attn_unit<REP_ATTN2>(lds, u, tid, AQ, AK, AVT, KIN(I_RELB), KIN(I_CQN) + j * 64, KIN(I_CKN) + j * 64, (bf16*)(ws + WS_END)); }
#endif
            if (PH(17)) moe_convert_phase(lds, KIN(I_WGATE) + (size_t)layer * NE * DM * FF, KIN(I_WUP) + (size_t)layer * NE * DM * FF, KIN(I_WDOWN) + (size_t)layer * NE * FF * DM, WGU, WD, (unsigned*)(ws + WS_CTL) + CW_Q + 64 * (2 * layer), MISC + 16, tid, wave, lane);
            GRID_BAR();
            for (int rep_ = 0; rep_ < REP_X1; ++rep_) if (PH(14)) acomb_phase(AO, KIN(I_CLAM) + j * 256, KIN(I_COUTN) + j * 128, 0.8f - 0.6f * expf(-0.3f * (float)layer), MIX, gw, NGW, lane);
            for (int rep_ = 0; rep_ < REP_X1; ++rep_) if (PH(14)) scomb_phase(OS, KIN(I_DOUTN) + j * 128, PO, ODD_N, 3072, true, MIX, 512, gw, NGW, lane);
            GRID_BAR();
        }
        if (PH(15)) {   pg8::Gemm g{MIX, (even ? WEO : WOO) + (size_t)j * DM * DM, DM, DM, DM}; pg8::Sched S; S.init(128, 4, G, bx, 20, 0);
            EpiResid E{layer == 0 ? KIN(I_X) : (const float*)nullptr, XB}; pg8::gemm_phase(lds, g, S, E, tid); }
        GRID_BAR();
        for (int rep_ = 0; rep_ < REP_NORM; ++rep_) if (PH(16)) norm_phase(lds, (const bf16*)XB, KIN(I_FFNN) + layer * DM, HN8, 1, KIN(I_ROUTER) + (size_t)layer * DM * NE, NE, AFF, bx, G, tid);
        GRID_BAR();
        for (int rep_ = 0; rep_ < REP_MISC; ++rep_) if (PH(18)) for (int u = bx; u < NB * NE; u += G) topk_unit(lds, AFF, SEL, IDX, GATE, u, tid);
        GRID_BAR();
        if (PH(20)) {
            pg8::Gemm g{(const bf16*)HN8, WGU, DM / 2, DM / 2, DM / 2}; pg8::Sched S; S.init(256, 16, G, bx, 4, 16);
            LAS int* tab = (LAS int*)(lds + 131072);
#pragma nounroll
            for (int i0 = 0; i0 < 16; i0 += 4) { int iv[4]; bool okv[4];
#pragma unroll
                for (int k = 0; k < 4; ++k) { pg8::Unit u; okv[k] = S.next(i0 + k, u) && tid < 256; iv[k] = 0; if (okv[k]) { const int slot = u.pm * 256 + tid; iv[k] = ((slot >> 10) & 3) * SEQ + IDX[slot]; } }
#pragma unroll
                for (int k = 0; k < 4; ++k) if (okv[k]) tab[(i0 + k) * 256 + tid] = iv[k]; }
            __syncthreads();
            EpiMoe1 E{(unsigned char*)HID, 1.f / 512.f}; pg8::gemm_phase_g8(lds, g, S, E, tid, tab);
#ifdef REP_G1
            __syncthreads(); pg8::gemm_phase_g8(lds, g, S, E, tid, tab);
#endif
            }
#if REP_MOEG > 1
        __syncthreads();
        if (PH(20)) {   pg8::Gemm g{XG, WGU, DM, DM, DM}; pg8::Sched S; S.init(256, 16, G, bx, 4, 16);
            EpiMoe1 E{(unsigned char*)HID, 1.f}; pg8::gemm_phase(lds, g, S, E, tid); }
#endif
        GRID_BAR();
        if (PH(21)) {   pg8::Gemm g{HID, WD, FF / 2, FF / 2, FF / 2}; pg8::Sched S; S.init(256, 4, G, bx, 4, 4);
            EpiFp8S E{YS8, DM, 64.f / 256.f}; pg8::gemm_phase8(lds, g, S, E, tid);
#ifdef REP_G2
            __syncthreads(); pg8::gemm_phase8(lds, g, S, E, tid);
#endif
            }
#if REP_MOEG > 1
        __syncthreads();
        if (PH(21)) {   pg8::Gemm g{HID, WD, FF, FF, FF}; pg8::Sched S; S.init(256, 4, G, bx, 4, 4);
            EpiBf16 E{YS, DM}; pg8::gemm_phase(lds, g, S, E, tid); }
#endif
        GRID_BAR();
        {   const int nl = layer + 1; const int nmode = nl >= 4 ? -1 : ((nl & 1) ? 2 : 0);
            combine_phase(lds, XB, nl >= 4 ? X : (float*)nullptr, SEL, GATE, YS8, nmode, KIN(I_MIXN) + (nl & 3) * DM, HN, KIN(I_ODWIN) + (size_t)(nl >> 1 & 1) * DM * ODD_IN + 3072, ODD_IN, AB, gw, NGW, tid); }
        GRID_BAR();
    }
#ifdef XTRA_BARS
    for (int i_ = 0; i_ < XTRA_BARS; ++i_) GRID_BAR();
#endif
    if (__hip_atomic_load((unsigned*)(ws + WS_CTL) + XB_TMO, __ATOMIC_RELAXED, __HIP_MEMORY_SCOPE_AGENT) != 0u) {
        const float q = __builtin_nanf(""); for (size_t i = (size_t)bx * 512 + tid; i < (size_t)T * DM; i += (size_t)G * 512) X[i] = q; }
}

#undef ws
#undef X
#undef XB
extern "C" void kernel_launch(void* const* d_in, const int* in_sizes, int n_in, void* d_out, int out_size, void* d_ws, size_t ws_size, hipStream_t stream) {
    static int grid = 0;
    if (grid == 0) {
        if (n_in != 32 || out_size != T * DM || ws_size < WS_END) { fprintf(stderr, "kernel_launch: unexpected shapes (n_in %d, out %d, ws %zu < %zu)\n", n_in, out_size, ws_size, (size_t)WS_END); grid = -1; return; }
        int dev = 0, cus = 0, per_cu = 0;
        if (hipGetDevice(&dev) != hipSuccess || hipDeviceGetAttribute(&cus, hipDeviceAttributeMultiprocessorCount, dev) != hipSuccess) { grid = -1; return; }
        if (hipFuncSetAttribute((const void*)hybrid_fwd, hipFuncAttributeMaxDynamicSharedMemorySize, LDS_BYTES) != hipSuccess) { fprintf(stderr, "kernel_launch: hipFuncSetAttribute failed\n"); grid = -1; return; }
        if (hipOccupancyMaxActiveBlocksPerMultiprocessor(&per_cu, (const void*)hybrid_fwd, 512, LDS_BYTES) != hipSuccess || per_cu < 1) fprintf(stderr, "kernel_launch: occupancy query says %d\n", per_cu);
        (void)hipGetLastError();
        grid = cus;
        if (grid > 256) grid = 256;
    }
    if (grid < 0) return;
    if (hipMemsetAsync((char*)d_ws + WS_CTL, 0, CTL_BYTES, stream) != hipSuccess) return;
    Args a{};
    for (int i = 0; i < 32; ++i) a.in[i] = (const float*)d_in[i];
    a.out = (float*)d_out; a.ws = (unsigned char*)d_ws;
    hipLaunchKernelGGL(hybrid_fwd, dim3(grid), dim3(512), LDS_BYTES, stream, a);
    const hipError_t le = hipPeekAtLastError();
    if (le != hipSuccess) fprintf(stderr, "kernel_launch: launch failed: %s\n", hipGetErrorName(le));
}
```

```cpp
#include <hip/hip_runtime.h>
#include <cstdio>
#include <cstdint>

#define GAS __attribute__((address_space(1)))
#define LAS __attribute__((address_space(3)))
typedef unsigned short bf16;
typedef unsigned short bf16_t;
typedef short bf16x8 __attribute__((ext_vector_type(8)));
typedef short bf16x4 __attribute__((ext_vector_type(4)));
typedef float f32x4 __attribute__((ext_vector_type(4)));
typedef float f32x2 __attribute__((ext_vector_type(2)));
typedef float f32x16 __attribute__((ext_vector_type(16)));
typedef unsigned u32x4 __attribute__((ext_vector_type(4)));
typedef unsigned u32x2 __attribute__((ext_vector_type(2)));

constexpr int NB = 4, SEQ = 8192, DM = 1024, T = NB * SEQ, NCH = SEQ / 64;
constexpr int EVEN_IN = 3072, ODD_IN = 3600, ODD_N = 3584;
constexpr int NE = 16, FF = 2048, CAP = 1024, NSLOT = NE * NB * CAP;
constexpr float EPS = 1e-6f;
constexpr float LOG2E = 1.4426950408889634f;

typedef float f32x2_t __attribute__((ext_vector_type(2))); typedef __bf16 bf16x2_t __attribute__((ext_vector_type(2)));
__device__ __forceinline__ unsigned cvt_pk_bf16(float lo, float hi) { f32x2_t v = {lo, hi}; bf16x2_t b = __builtin_convertvector(v, bf16x2_t); return __builtin_bit_cast(unsigned, b); }
__device__ __forceinline__ float bf2f(unsigned short b) { return __uint_as_float(((unsigned)b) << 16); }
__device__ __forceinline__ float bflo(unsigned w) { return __uint_as_float(w << 16); }
__device__ __forceinline__ float bfhi(unsigned w) { return __uint_as_float(w & 0xffff0000u); }
__device__ __forceinline__ unsigned short f2bf(float f) { return (unsigned short)(cvt_pk_bf16(f, 0.f) & 0xffffu); }
__device__ __forceinline__ float wave_sum(float v) {
    v += __int_as_float(__builtin_amdgcn_update_dpp(0, __float_as_int(v), 0xB1, 0xf, 0xf, true));
    v += __int_as_float(__builtin_amdgcn_update_dpp(0, __float_as_int(v), 0x4E, 0xf, 0xf, true));
    v += __int_as_float(__builtin_amdgcn_update_dpp(0, __float_as_int(v), 0x141, 0xf, 0xf, true));
    v += __int_as_float(__builtin_amdgcn_update_dpp(0, __float_as_int(v), 0x140, 0xf, 0xf, true));
    const int vi = __float_as_int(v);
    const float r0 = __int_as_float(__builtin_amdgcn_readlane(vi, 0)), r1 = __int_as_float(__builtin_amdgcn_readlane(vi, 16)), r2 = __int_as_float(__builtin_amdgcn_readlane(vi, 32)), r3 = __int_as_float(__builtin_amdgcn_readlane(vi, 48));
    return (r0 + r1) + (r2 + r3);
}
__device__ __forceinline__ float half_sum(float v, int lane) {
    v += __int_as_float(__builtin_amdgcn_update_dpp(0, __float_as_int(v), 0xB1, 0xf, 0xf, true));
    v += __int_as_float(__builtin_amdgcn_update_dpp(0, __float_as_int(v), 0x4E, 0xf, 0xf, true));
    v += __int_as_float(__builtin_amdgcn_update_dpp(0, __float_as_int(v), 0x141, 0xf, 0xf, true));
    v += __int_as_float(__builtin_amdgcn_update_dpp(0, __float_as_int(v), 0x140, 0xf, 0xf, true));
    const int vi = __float_as_int(v);
    const float r0 = __int_as_float(__builtin_amdgcn_readlane(vi, 0)), r1 = __int_as_float(__builtin_amdgcn_readlane(vi, 16)), r2 = __int_as_float(__builtin_amdgcn_readlane(vi, 32)), r3 = __int_as_float(__builtin_amdgcn_readlane(vi, 48));
    return lane < 32 ? r0 + r1 : r2 + r3;
}
typedef short v4s_ __attribute__((ext_vector_type(4)));
__device__ __forceinline__ u32x2 lds_tr16(const LAS unsigned char* p) { const v4s_ r = __builtin_amdgcn_ds_read_tr16_b64_v4i16((LAS v4s_*)p); return __builtin_bit_cast(u32x2, r); }
__device__ __forceinline__ float shfl_xor32(float v, int lane) { return __int_as_float(__builtin_amdgcn_ds_bpermute((lane ^ 32) << 2, __float_as_int(v))); }
__device__ __forceinline__ float shfl_up_f(float v, int o, int lane) { return __int_as_float(__builtin_amdgcn_ds_bpermute((lane >= o ? lane - o : lane) << 2, __float_as_int(v))); }
__device__ __forceinline__ unsigned shfl_up_u(unsigned v, int o, int lane) { return (unsigned)__builtin_amdgcn_ds_bpermute((lane >= o ? lane - o : lane) << 2, (int)v); }
#if defined(FP8EMU) || defined(EMU2) || defined(EMU3)
__device__ __forceinline__ float q8(float x, float sc) { const int p = __builtin_amdgcn_cvt_pk_fp8_f32(x * sc, 0.f, 0, false); return __builtin_amdgcn_cvt_f32_fp8(p, 0) * (1.f / sc); }
#else
__device__ __forceinline__ float q8(float x, float) { return x; }
#endif
__device__ __forceinline__ unsigned pk_fp8x4(float a, float b, float c, float d) { int p = __builtin_amdgcn_cvt_pk_fp8_f32(a, b, 0, false); p = __builtin_amdgcn_cvt_pk_fp8_f32(c, d, p, true); return (unsigned)p; }
#ifdef EMU3
#define Q3(x, s) q8((x), (s))
#else
#define Q3(x, s) (x)
#endif
#if defined(EMU2) && (EMU2 & 1)
#define QM(x) q8((x), 16.f)
#else
#define QM(x) (x)
#endif
__device__ __forceinline__ float fast_exp(float x) { return __builtin_amdgcn_exp2f(x * LOG2E); }
__device__ __forceinline__ float fast_log(float x) { return __builtin_amdgcn_logf(x) * 0.6931471805599453f; }
__device__ __forceinline__ float fast_rcp(float x) { return __builtin_amdgcn_rcpf(x); }
__device__ __forceinline__ float sigmoidf_(float x) { return fast_rcp(1.f + fast_exp(-x)); }
__device__ __forceinline__ float siluf_(float x) { return x * sigmoidf_(x); }
__device__ __forceinline__ float gelu_tanh(float x) { const float u = 1.5957691216057308f * (x + 0.044715f * x * x * x); return x * fast_rcp(1.f + fast_exp(-u)); }
__device__ __forceinline__ void lds_barrier() { asm volatile("s_waitcnt lgkmcnt(0)" ::: "memory"); __builtin_amdgcn_s_barrier(); asm volatile("" ::: "memory"); }
#define LDS_WAIT() asm volatile("s_waitcnt lgkmcnt(0)" ::: "memory")
#define VM_WAIT() asm volatile("s_waitcnt vmcnt(0)" ::: "memory")

struct EpiBf16; struct EpiBf16S;
namespace pg8 {
#define PG8_LAS __attribute__((address_space(3)))
constexpr int BM = 256, BK = 64, HALF = 128, HTB = HALF * BK * 2, STAGE_BYTES = 8 * HTB, NXCD = 8, WGM = 8;
__host__ __device__ __forceinline__ int lds_byte(int r, int c) { const int st = (r >> 4) * 2 + (c >> 5), rr = r & 15, cc = c & 31, ob = rr * 64 + cc * 2; return st * 1024 + (ob ^ (((ob >> 9) & 1) << 5)); }
__host__ __device__ __forceinline__ void stage_rc(int b, int& R, int& C) { const int st = b / 1024, sb = b % 1024, swz = sb ^ (((sb >> 9) & 1) << 5); R = (st >> 1) * 16 + swz / 64; C = (st & 1) * 32 + (swz % 64) / 2; }
__host__ __device__ __forceinline__ int perm32(int rho) { const int n = rho >> 4, i = rho & 15; return 8 * (i >> 2) + 4 * n + (i & 3); }

struct Unit { int pm, pn, pb; };
struct Gemm { const bf16_t* A; const bf16_t* Bt; int K, lda, ldb; };

struct Sched {
    int nM, nN, nwg, G, c, gdiv, gmul;
    __device__ __forceinline__ void init(int nM_, int nN_, int G_, int c_, int gdiv_, int gmul_) { nM = nM_; nN = nN_; nwg = nM * nN; G = G_; c = c_; gdiv = gdiv_; gmul = gmul_; }
    __device__ __forceinline__ bool next(int i, Unit& u) const {
        const int L = i * G + c; if (L >= nwg) return false;
        int wgid = L; { const int q = nwg / NXCD, r = nwg % NXCD, xcd = wgid % NXCD, off = wgid / NXCD; wgid = (xcd < r ? xcd * (q + 1) : r * (q + 1) + (xcd - r) * q) + off; }
        const int nig = WGM * nN, gid = wgid / nig, fm = gid * WGM, gsz = (nM - fm) < WGM ? (nM - fm) : WGM;
        u.pm = fm + ((wgid % nig) % gsz); u.pn = (wgid % nig) / gsz; u.pb = (u.pm >> gdiv) * gmul + u.pn; return true;
    }
};

template <class Epi>
__device__ __forceinline__ void gemm_phase(PG8_LAS unsigned char* lds, const Gemm g, const Sched& S, const Epi& E, const int tid) {
    const int wid = __builtin_amdgcn_readfirstlane(tid >> 6), lane = tid & 63, wr = wid >> 2, wc = wid & 3, fr = lane & 15, fq = lane >> 4;
    const int K = g.K, nt = K / BK;
    unsigned voffA[2], voffB[2];
#pragma unroll
    for (int i = 0; i < 2; ++i) { int R, C; stage_rc(tid * 16 + i * 8192, R, C); const int Rb = ((R & ~31) + perm32(R & 31));
        voffA[i] = (unsigned)(R * g.lda + C) * 2u; voffB[i] = (unsigned)(Rb * g.ldb + C) * 2u; }
    const size_t kstep = (size_t)(BK * 2);
    const size_t hstepA = (size_t)HALF * g.lda * 2, hstepB = (size_t)HALF * g.ldb * 2;
    const size_t tstepA = 2 * hstepA, tstepB = 2 * hstepB;
    const unsigned ldsw = (unsigned)wid * 1024u;
    const int aoff = lds_byte(wr * 64 + fr, fq * 8), boff = lds_byte(wc * 32 + fr, fq * 8);
#define PG8_SA(b, h) (((b) * 2 + (h)) * HTB)
#define PG8_SB(b, h) ((4 + (b) * 2 + (h)) * HTB)
#define PG8_STAGE(bufoff, gbase, voff) do { _Pragma("unroll") for (int _i = 0; _i < 2; ++_i) \
        __builtin_amdgcn_global_load_lds((const unsigned*)((const char*)(gbase) + (voff)[_i]), (PG8_LAS unsigned*)(lds + (bufoff) + ldsw + _i * 8192), 16, 0, 0); } while (0)
#define PG8_LDA(dst, b, h) do { _Pragma("unroll") for (int m = 0; m < 4; ++m) _Pragma("unroll") for (int k = 0; k < 2; ++k) dst[m][k] = *(const PG8_LAS bf16x8*)(lds + PG8_SA(b, h) + aoff + m * 2048 + k * 1024); } while (0)
#define PG8_LDB(dst, b, h) do { _Pragma("unroll") for (int n = 0; n < 2; ++n) _Pragma("unroll") for (int k = 0; k < 2; ++k) dst[n][k] = *(const PG8_LAS bf16x8*)(lds + PG8_SB(b, h) + boff + n * 2048 + k * 1024); } while (0)
#define PG8_MMA(ai, bj, At, Bt) do { __builtin_amdgcn_s_setprio(1); _Pragma("unroll") for (int m = 0; m < 4; ++m) _Pragma("unroll") for (int n = 0; n < 2; ++n) _Pragma("unroll") for (int k = 0; k < 2; ++k) \
        acc[ai][bj][m][n] = __builtin_amdgcn_mfma_f32_16x16x32_bf16(Bt[n][k], At[m][k], acc[ai][bj][m][n], 0, 0, 0); __builtin_amdgcn_s_setprio(0); } while (0)
#define PG8_WAIT_V(n) asm volatile("s_waitcnt vmcnt(" #n ")" ::: "memory")
#define PG8_WAIT_L(n) asm volatile("s_waitcnt lgkmcnt(" #n ")" ::: "memory")
#define PG8_BAR __builtin_amdgcn_s_barrier()
#define PG8_SCHED __builtin_amdgcn_sched_barrier(0)
    Unit cur, nxt; int ui = 0;
    if (!S.next(0, cur)) return;
    f32x4 acc[2][2][4][2];
#pragma unroll
    for (int a = 0; a < 2; ++a)
#pragma unroll
        for (int b = 0; b < 2; ++b)
#pragma unroll
            for (int m = 0; m < 4; ++m)
#pragma unroll
                for (int n = 0; n < 2; ++n) acc[a][b][m][n] = (f32x4){0.f, 0.f, 0.f, 0.f};
    bf16x8 At[4][2], B0[2][2], B1[2][2];
    const char* cA = (const char*)g.A + (size_t)cur.pm * tstepA; const char* cB = (const char*)g.Bt + (size_t)cur.pb * tstepB;
    PG8_STAGE(PG8_SB(0, 0), cB, voffB); PG8_STAGE(PG8_SB(0, 1), cB + hstepB, voffB); PG8_STAGE(PG8_SA(0, 0), cA, voffA); PG8_STAGE(PG8_SA(0, 1), cA + hstepA, voffA);
    if (wr == 1) PG8_BAR;
    PG8_WAIT_V(2); PG8_BAR;
    PG8_STAGE(PG8_SB(1, 0), cB + kstep, voffB); PG8_STAGE(PG8_SA(1, 0), cA + kstep, voffA); PG8_STAGE(PG8_SB(1, 1), cB + hstepB + kstep, voffB);
    PG8_WAIT_V(6); PG8_BAR;
    for (;;) {
        const bool has_next = S.next(ui + 1, nxt);
        const char* nA = has_next ? (const char*)g.A + (size_t)nxt.pm * tstepA : cA; const char* nB = has_next ? (const char*)g.Bt + (size_t)nxt.pb * tstepB : cB;
#pragma nounroll
        for (int t = 0; t < nt; t += 2) {
            const bool last = (t == nt - 2);
            const char* a1 = cA + (size_t)(t + 1) * kstep;
            const char* a2 = last ? nA : cA + (size_t)(t + 2) * kstep; const char* b2 = last ? nB : cB + (size_t)(t + 2) * kstep;
            const char* a3 = a2 + kstep; const char* b3 = b2 + kstep;
            PG8_LDB(B0, 0, 0); PG8_LDB(B1, 0, 1); PG8_SCHED; PG8_LDA(At, 0, 0); PG8_STAGE(PG8_SA(1, 1), a1 + hstepA, voffA);
            PG8_WAIT_V(8); PG8_WAIT_L(0); PG8_BAR; PG8_MMA(0, 0, At, B0); PG8_MMA(0, 1, At, B1); PG8_BAR; PG8_SCHED;
            PG8_LDA(At, 0, 1); PG8_STAGE(PG8_SB(0, 0), b2, voffB); PG8_STAGE(PG8_SB(0, 1), b2 + hstepB, voffB); PG8_STAGE(PG8_SA(0, 0), a2, voffA);
            PG8_WAIT_V(8); PG8_WAIT_L(0); PG8_BAR; PG8_MMA(1, 0, At, B0); PG8_MMA(1, 1, At, B1); PG8_BAR; PG8_SCHED;
            PG8_LDB(B0, 1, 0); PG8_LDB(B1, 1, 1); PG8_SCHED; PG8_LDA(At, 1, 0); PG8_STAGE(PG8_SA(0, 1), a2 + hstepA, voffA);
            PG8_WAIT_V(8); PG8_WAIT_L(0); PG8_BAR; PG8_MMA(0, 0, At, B0); PG8_MMA(0, 1, At, B1); PG8_BAR; PG8_SCHED;
            PG8_LDA(At, 1, 1); PG8_STAGE(PG8_SB(1, 0), b3, voffB); PG8_STAGE(PG8_SB(1, 1), b3 + hstepB, voffB); PG8_STAGE(PG8_SA(1, 0), a3, voffA);
            PG8_WAIT_V(8); PG8_WAIT_L(0); PG8_BAR; PG8_MMA(1, 0, At, B0); PG8_MMA(1, 1, At, B1); PG8_BAR; PG8_SCHED;
        }
        if (wr == 0) PG8_BAR;
        E(acc, cur, wr, wc, fr, fq);
#ifdef EPI_DUP
        if (__is_same(Epi, ::EpiBf16) || __is_same(Epi, ::EpiBf16S)) { asm volatile("" ::: "memory"); E(acc, cur, wr, wc, fr, fq); }
#endif
        if (!has_next) break;
#pragma unroll
        for (int a = 0; a < 2; ++a)
#pragma unroll
            for (int b = 0; b < 2; ++b)
#pragma unroll
                for (int m = 0; m < 4; ++m)
#pragma unroll
                    for (int n = 0; n < 2; ++n) acc[a][b][m][n] = (f32x4){0.f, 0.f, 0.f, 0.f};
        cur = nxt; cA = nA; cB = nB; ++ui;
        if (wr == 1) PG8_BAR;
    }
    PG8_WAIT_V(0);
    PG8_BAR;
#undef PG8_SA
#undef PG8_SB
#undef PG8_STAGE
#undef PG8_LDA
#undef PG8_LDB
#undef PG8_MMA
#undef PG8_WAIT_V
#undef PG8_WAIT_L
#undef PG8_BAR
#undef PG8_SCHED
}
template <class Epi>
__device__ __forceinline__ void gemm_phase8(PG8_LAS unsigned char* lds, const Gemm g, const Sched& S, const Epi& E, const int tid) {
    const int wid = __builtin_amdgcn_readfirstlane(tid >> 6), lane = tid & 63, wr = wid >> 2, wc = wid & 3, fr = lane & 15, fq = lane >> 4;
    const int K = g.K, nt = K / BK;
    unsigned voffA[2], voffB[2];
#pragma unroll
    for (int i = 0; i < 2; ++i) { int R, C; stage_rc(tid * 16 + i * 8192, R, C); const int Rb = ((R & ~31) + perm32(R & 31));
        voffA[i] = (unsigned)(R * g.lda + C) * 2u; voffB[i] = (unsigned)(Rb * g.ldb + C) * 2u; }
    const size_t kstep = (size_t)(BK * 2);
    const size_t hstepA = (size_t)HALF * g.lda * 2, hstepB = (size_t)HALF * g.ldb * 2;
    const size_t tstepA = 2 * hstepA, tstepB = 2 * hstepB;
    const unsigned ldsw = (unsigned)wid * 1024u;
    const int aoff0 = lds_byte(wr * 64 + fr, fq * 8), aoff1 = lds_byte(wr * 64 + fr, 32 + fq * 8), boff0 = lds_byte(wc * 32 + fr, fq * 8), boff1 = lds_byte(wc * 32 + fr, 32 + fq * 8);
#define PG8_SA(b, h) (((b) * 2 + (h)) * HTB)
#define PG8_SB(b, h) ((4 + (b) * 2 + (h)) * HTB)
#define PG8_STAGE(bufoff, gbase, voff) do { _Pragma("unroll") for (int _i = 0; _i < 2; ++_i) \
        __builtin_amdgcn_global_load_lds((const unsigned*)((const char*)(gbase) + (voff)[_i]), (PG8_LAS unsigned*)(lds + (bufoff) + ldsw + _i * 8192), 16, 0, 0); } while (0)
#define PG8_LDA(dst, b, h) do { _Pragma("unroll") for (int m = 0; m < 4; ++m) { const v4i_ lo_ = *(const PG8_LAS v4i_*)(lds + PG8_SA(b, h) + aoff0 + m * 2048), hi_ = *(const PG8_LAS v4i_*)(lds + PG8_SA(b, h) + aoff1 + m * 2048); dst[m] = __builtin_shufflevector(lo_, hi_, 0, 1, 2, 3, 4, 5, 6, 7); } } while (0)
#define PG8_LDB(dst, b, h) do { _Pragma("unroll") for (int n = 0; n < 2; ++n) { const v4i_ lo_ = *(const PG8_LAS v4i_*)(lds + PG8_SB(b, h) + boff0 + n * 2048), hi_ = *(const PG8_LAS v4i_*)(lds + PG8_SB(b, h) + boff1 + n * 2048); dst[n] = __builtin_shufflevector(lo_, hi_, 0, 1, 2, 3, 4, 5, 6, 7); } } while (0)
#define PG8_MMA(ai, bj, At, Bt) do { __builtin_amdgcn_s_setprio(1); _Pragma("unroll") for (int m = 0; m < 4; ++m) _Pragma("unroll") for (int n = 0; n < 2; ++n) \
        asm volatile("v_mfma_scale_f32_16x16x128_f8f6f4 %0, %1, %2, %0, %3, %3 op_sel_hi:[0,0,0]" : "+v"(acc[ai][bj][m][n]) : "v"(Bt[n]), "v"(At[m]), "v"(sc127)); __builtin_amdgcn_s_setprio(0); } while (0)
#define PG8_WAIT_V(n) asm volatile("s_waitcnt vmcnt(" #n ")" ::: "memory")
#define PG8_WAIT_L(n) asm volatile("s_waitcnt lgkmcnt(" #n ")" ::: "memory")
#define PG8_BAR __builtin_amdgcn_s_barrier()
#define PG8_SCHED __builtin_amdgcn_sched_barrier(0)
    Unit cur, nxt; int ui = 0;
    if (!S.next(0, cur)) return;
    f32x4 acc[2][2][4][2];
#pragma unroll
    for (int a = 0; a < 2; ++a)
#pragma unroll
        for (int b = 0; b < 2; ++b)
#pragma unroll
            for (int m = 0; m < 4; ++m)
#pragma unroll
                for (int n = 0; n < 2; ++n) acc[a][b][m][n] = (f32x4){0.f, 0.f, 0.f, 0.f};
    typedef int v4i_ __attribute__((ext_vector_type(4))); typedef int v8i_ __attribute__((ext_vector_type(8)));
    v8i_ At[4], B0[2], B1[2]; const int sc127 = 0x7f7f7f7f;
    const char* cA = (const char*)g.A + (size_t)cur.pm * tstepA; const char* cB = (const char*)g.Bt + (size_t)cur.pb * tstepB;
    PG8_STAGE(PG8_SB(0, 0), cB, voffB); PG8_STAGE(PG8_SB(0, 1), cB + hstepB, voffB); PG8_STAGE(PG8_SA(0, 0), cA, voffA); PG8_STAGE(PG8_SA(0, 1), cA + hstepA, voffA);
    if (wr == 1) PG8_BAR;
    PG8_WAIT_V(2); PG8_BAR;
    PG8_STAGE(PG8_SB(1, 0), cB + kstep, voffB); PG8_STAGE(PG8_SA(1, 0), cA + kstep, voffA); PG8_STAGE(PG8_SB(1, 1), cB + hstepB + kstep, voffB);
    PG8_WAIT_V(6); PG8_BAR;
    for (;;) {
        const bool has_next = S.next(ui + 1, nxt);
        const char* nA = has_next ? (const char*)g.A + (size_t)nxt.pm * tstepA : cA; const char* nB = has_next ? (const char*)g.Bt + (size_t)nxt.pb * tstepB : cB;
#pragma nounroll
        for (int t = 0; t < nt; t += 2) {
            const bool last = (t == nt - 2);
            const char* a1 = cA + (size_t)(t + 1) * kstep;
            const char* a2 = last ? nA : cA + (size_t)(t + 2) * kstep; const char* b2 = last ? nB : cB + (size_t)(t + 2) * kstep;
            const char* a3 = a2 + kstep; const char* b3 = b2 + kstep;
            PG8_LDB(B0, 0, 0); PG8_LDB(B1, 0, 1); PG8_SCHED; PG8_LDA(At, 0, 0); PG8_STAGE(PG8_SA(1, 1), a1 + hstepA, voffA);
            PG8_WAIT_V(8); PG8_WAIT_L(0); PG8_BAR; PG8_MMA(0, 0, At, B0); PG8_MMA(0, 1, At, B1); PG8_BAR; PG8_SCHED;
            PG8_LDA(At, 0, 1); PG8_STAGE(PG8_SB(0, 0), b2, voffB); PG8_STAGE(PG8_SB(0, 1), b2 + hstepB, voffB); PG8_STAGE(PG8_SA(0, 0), a2, voffA);
            PG8_WAIT_V(8); PG8_WAIT_L(0); PG8_BAR; PG8_MMA(1, 0, At, B0); PG8_MMA(1, 1, At, B1); PG8_BAR; PG8_SCHED;
            PG8_LDB(B0, 1, 0); PG8_LDB(B1, 1, 1); PG8_SCHED; PG8_LDA(At, 1, 0); PG8_STAGE(PG8_SA(0, 1), a2 + hstepA, voffA);
            PG8_WAIT_V(8); PG8_WAIT_L(0); PG8_BAR; PG8_MMA(0, 0, At, B0); PG8_MMA(0, 1, At, B1); PG8_BAR; PG8_SCHED;
            PG8_LDA(At, 1, 1); PG8_STAGE(PG8_SB(1, 0), b3, voffB); PG8_STAGE(PG8_SB(1, 1), b3 + hstepB, voffB); PG8_STAGE(PG8_SA(1, 0), a3, voffA);
            PG8_WAIT_V(8); PG8_WAIT_L(0); PG8_BAR; PG8_MMA(1, 0, At, B0); PG8_MMA(1, 1, At, B1); PG8_BAR; PG8_SCHED;
        }
        if (wr == 0) PG8_BAR;
        asm volatile("s_nop 15\n\ts_nop 15" ::: "memory");
        E(acc, cur, wr, wc, fr, fq);
#ifdef EPI_DUP
        if (__is_same(Epi, ::EpiBf16) || __is_same(Epi, ::EpiBf16S)) { asm volatile("" ::: "memory"); E(acc, cur, wr, wc, fr, fq); }
#endif
        if (!has_next) break;
#pragma unroll
        for (int a = 0; a < 2; ++a)
#pragma unroll
            for (int b = 0; b < 2; ++b)
#pragma unroll
                for (int m = 0; m < 4; ++m)
#pragma unroll
                    for (int n = 0; n < 2; ++n) acc[a][b][m][n] = (f32x4){0.f, 0.f, 0.f, 0.f};
        cur = nxt; cA = nA; cB = nB; ++ui;
        if (wr == 1) PG8_BAR;
    }
    PG8_WAIT_V(0);
    PG8_BAR;
#undef PG8_SA
#undef PG8_SB
#undef PG8_STAGE
#undef PG8_LDA
#undef PG8_LDB
#undef PG8_MMA
#undef PG8_WAIT_V
#undef PG8_WAIT_L
#undef PG8_BAR
#undef PG8_SCHED
}
template <class Epi>
__device__ __forceinline__ void gemm_phase_g(PG8_LAS unsigned char* lds, const Gemm g, const Sched& S, const Epi& E, const int tid, const PG8_LAS int* tab) {
    const int wid = __builtin_amdgcn_readfirstlane(tid >> 6), lane = tid & 63, wr = wid >> 2, wc = wid & 3, fr = lane & 15, fq = lane >> 4;
    const int K = g.K, nt = K / BK;
    unsigned voffB[2]; int RA0, CA0, RA1, CA1;
    {   int R, C; stage_rc(tid * 16, R, C); RA0 = R; CA0 = C; voffB[0] = (unsigned)(((R & ~31) + perm32(R & 31)) * g.ldb + C) * 2u;
        stage_rc(tid * 16 + 8192, R, C); RA1 = R; CA1 = C; voffB[1] = (unsigned)(((R & ~31) + perm32(R & 31)) * g.ldb + C) * 2u; }
    struct V2 { unsigned a, b; };
    V2 vA0, vA1, nA0, nA1;
#define PG8_GVOFF(d0, d1, ord) do { d0.a = (unsigned)(tab[(ord) * 256 + RA0] * g.lda + CA0) * 2u; d0.b = (unsigned)(tab[(ord) * 256 + RA1] * g.lda + CA1) * 2u; \
        d1.a = (unsigned)(tab[(ord) * 256 + 128 + RA0] * g.lda + CA0) * 2u; d1.b = (unsigned)(tab[(ord) * 256 + 128 + RA1] * g.lda + CA1) * 2u; } while (0)
#define PG8_STAGEA(bufoff, gbase, v2) do { \
        __builtin_amdgcn_global_load_lds((const unsigned*)((const char*)(gbase) + (v2).a), (PG8_LAS unsigned*)(lds + (bufoff) + ldsw), 16, 0, 0); \
        __builtin_amdgcn_global_load_lds((const unsigned*)((const char*)(gbase) + (v2).b), (PG8_LAS unsigned*)(lds + (bufoff) + ldsw + 8192), 16, 0, 0); } while (0)
    const size_t kstep = (size_t)(BK * 2);
    const size_t hstepB = (size_t)HALF * g.ldb * 2;
    const size_t tstepB = 2 * hstepB;
    const unsigned ldsw = (unsigned)wid * 1024u;
    const int aoff = lds_byte(wr * 64 + fr, fq * 8), boff = lds_byte(wc * 32 + fr, fq * 8);
#define PG8_SA(b, h) (((b) * 2 + (h)) * HTB)
#define PG8_SB(b, h) ((4 + (b) * 2 + (h)) * HTB)
#define PG8_STAGE(bufoff, gbase, voff) do { _Pragma("unroll") for (int _i = 0; _i < 2; ++_i) \
        __builtin_amdgcn_global_load_lds((const unsigned*)((const char*)(gbase) + (voff)[_i]), (PG8_LAS unsigned*)(lds + (bufoff) + ldsw + _i * 8192), 16, 0, 0); } while (0)
#define PG8_LDA(dst, b, h) do { _Pragma("unroll") for (int m = 0; m < 4; ++m) _Pragma("unroll") for (int k = 0; k < 2; ++k) dst[m][k] = *(const PG8_LAS bf16x8*)(lds + PG8_SA(b, h) + aoff + m * 2048 + k * 1024); } while (0)
#define PG8_LDB(dst, b, h) do { _Pragma("unroll") for (int n = 0; n < 2; ++n) _Pragma("unroll") for (int k = 0; k < 2; ++k) dst[n][k] = *(const PG8_LAS bf16x8*)(lds + PG8_SB(b, h) + boff + n * 2048 + k * 1024); } while (0)
#define PG8_MMA(ai, bj, At, Bt) do { __builtin_amdgcn_s_setprio(1); _Pragma("unroll") for (int m = 0; m < 4; ++m) _Pragma("unroll") for (int n = 0; n < 2; ++n) _Pragma("unroll") for (int k = 0; k < 2; ++k) \
        acc[ai][bj][m][n] = __builtin_amdgcn_mfma_f32_16x16x32_bf16(Bt[n][k], At[m][k], acc[ai][bj][m][n], 0, 0, 0); __builtin_amdgcn_s_setprio(0); } while (0)
#define PG8_WAIT_V(n) asm volatile("s_waitcnt vmcnt(" #n ")" ::: "memory")
#define PG8_WAIT_L(n) asm volatile("s_waitcnt lgkmcnt(" #n ")" ::: "memory")
#define PG8_BAR __builtin_amdgcn_s_barrier()
#define PG8_SCHED __builtin_amdgcn_sched_barrier(0)
    Unit cur, nxt; int ui = 0;
    if (!S.next(0, cur)) return;
    f32x4 acc[2][2][4][2];
#pragma unroll
    for (int a = 0; a < 2; ++a)
#pragma unroll
        for (int b = 0; b < 2; ++b)
#pragma unroll
            for (int m = 0; m < 4; ++m)
#pragma unroll
                for (int n = 0; n < 2; ++n) acc[a][b][m][n] = (f32x4){0.f, 0.f, 0.f, 0.f};
    bf16x8 At[4][2], B0[2][2], B1[2][2];
    PG8_GVOFF(vA0, vA1, 0);
    const char* cA = (const char*)g.A; const char* cB = (const char*)g.Bt + (size_t)cur.pb * tstepB;
    PG8_STAGE(PG8_SB(0, 0), cB, voffB); PG8_STAGE(PG8_SB(0, 1), cB + hstepB, voffB); PG8_STAGEA(PG8_SA(0, 0), cA, vA0); PG8_STAGEA(PG8_SA(0, 1), cA, vA1);
    if (wr == 1) PG8_BAR;
    PG8_WAIT_V(2); PG8_BAR;
    PG8_STAGE(PG8_SB(1, 0), cB + kstep, voffB); PG8_STAGEA(PG8_SA(1, 0), cA + kstep, vA0); PG8_STAGE(PG8_SB(1, 1), cB + hstepB + kstep, voffB);
    PG8_WAIT_V(6); PG8_BAR;
    for (;;) {
        const bool has_next = S.next(ui + 1, nxt);
        if (has_next) PG8_GVOFF(nA0, nA1, ui + 1); else { nA0 = vA0; nA1 = vA1; }
        const char* nA = cA; const char* nB = has_next ? (const char*)g.Bt + (size_t)nxt.pb * tstepB : cB;
#pragma nounroll
        for (int t = 0; t < nt; t += 2) {
            const bool last = (t == nt - 2);
            const char* a1 = cA + (size_t)(t + 1) * kstep;
            const char* a2 = last ? nA : cA + (size_t)(t + 2) * kstep; const char* b2 = last ? nB : cB + (size_t)(t + 2) * kstep;
            const char* a3 = a2 + kstep; const char* b3 = b2 + kstep;
            V2 s0, s1; s0.a = last ? nA0.a : vA0.a; s0.b = last ? nA0.b : vA0.b; s1.a = last ? nA1.a : vA1.a; s1.b = last ? nA1.b : vA1.b;
            PG8_LDB(B0, 0, 0); PG8_LDB(B1, 0, 1); PG8_SCHED; PG8_LDA(At, 0, 0); PG8_STAGEA(PG8_SA(1, 1), a1, vA1);
            PG8_WAIT_V(8); PG8_WAIT_L(0); PG8_BAR; PG8_MMA(0, 0, At, B0); PG8_MMA(0, 1, At, B1); PG8_BAR; PG8_SCHED;
            PG8_LDA(At, 0, 1); PG8_STAGE(PG8_SB(0, 0), b2, voffB); PG8_STAGE(PG8_SB(0, 1), b2 + hstepB, voffB); PG8_STAGEA(PG8_SA(0, 0), a2, s0);
            PG8_WAIT_V(8); PG8_WAIT_L(0); PG8_BAR; PG8_MMA(1, 0, At, B0); PG8_MMA(1, 1, At, B1); PG8_BAR; PG8_SCHED;
            PG8_LDB(B0, 1, 0); PG8_LDB(B1, 1, 1); PG8_SCHED; PG8_LDA(At, 1, 0); PG8_STAGEA(PG8_SA(0, 1), a2, s1);
            PG8_WAIT_V(8); PG8_WAIT_L(0); PG8_BAR; PG8_MMA(0, 0, At, B0); PG8_MMA(0, 1, At, B1); PG8_BAR; PG8_SCHED;
            PG8_LDA(At, 1, 1); PG8_STAGE(PG8_SB(1, 0), b3, voffB); PG8_STAGE(PG8_SB(1, 1), b3 + hstepB, voffB); PG8_STAGEA(PG8_SA(1, 0), a3, s0);
            PG8_WAIT_V(8); PG8_WAIT_L(0); PG8_BAR; PG8_MMA(1, 0, At, B0); PG8_MMA(1, 1, At, B1); PG8_BAR; PG8_SCHED;
        }
        if (wr == 0) PG8_BAR;
        E(acc, cur, wr, wc, fr, fq);
#ifdef EPI_DUP
        if (__is_same(Epi, ::EpiBf16) || __is_same(Epi, ::EpiBf16S)) { asm volatile("" ::: "memory"); E(acc, cur, wr, wc, fr, fq); }
#endif
        if (!has_next) break;
#pragma unroll
        for (int a = 0; a < 2; ++a)
#pragma unroll
            for (int b = 0; b < 2; ++b)
#pragma unroll
                for (int m = 0; m < 4; ++m)
#pragma unroll
                    for (int n = 0; n < 2; ++n) acc[a][b][m][n] = (f32x4){0.f, 0.f, 0.f, 0.f};
        cur = nxt; cB = nB; ++ui; vA0 = nA0; vA1 = nA1;
        if (wr == 1) PG8_BAR;
    }
    PG8_WAIT_V(0);
    PG8_BAR;
#undef PG8_GVOFF
#undef PG8_STAGEA
#undef PG8_SA
#undef PG8_SB
#undef PG8_STAGE
#undef PG8_LDA
#undef PG8_LDB
#undef PG8_MMA
#undef PG8_WAIT_V
#undef PG8_WAIT_L
#undef PG8_BAR
#undef PG8_SCHED
}
template <class Epi>
__device__ __forceinline__ void gemm_phase_g8(PG8_LAS unsigned char* lds, const Gemm g, const Sched& S, const Epi& E, const int tid, const PG8_LAS int* tab) {
    const int wid = __builtin_amdgcn_readfirstlane(tid >> 6), lane = tid & 63, wr = wid >> 2, wc = wid & 3, fr = lane & 15, fq = lane >> 4;
    const int K = g.K, nt = K / BK;
    unsigned voffB[2];
    {   int R, C; stage_rc(tid * 16, R, C); voffB[0] = (unsigned)(((R & ~31) + perm32(R & 31)) * g.ldb + C) * 2u;
        stage_rc(tid * 16 + 8192, R, C); voffB[1] = (unsigned)(((R & ~31) + perm32(R & 31)) * g.ldb + C) * 2u; }
    struct V2 { unsigned a, b; };
    V2 vA0, vA1;
#define PG8_GVOFF(d0, d1, ord) do { int R0_, C0_, R1_, C1_; stage_rc(tid * 16, R0_, C0_); stage_rc(tid * 16 + 8192, R1_, C1_); \
        d0.a = (unsigned)(tab[(ord) * 256 + R0_] * g.lda + C0_) * 2u; d0.b = (unsigned)(tab[(ord) * 256 + R1_] * g.lda + C1_) * 2u; \
        d1.a = (unsigned)(tab[(ord) * 256 + 128 + R0_] * g.lda + C0_) * 2u; d1.b = (unsigned)(tab[(ord) * 256 + 128 + R1_] * g.lda + C1_) * 2u; } while (0)
#define PG8_STAGEA(bufoff, gbase, v2) do { \
        __builtin_amdgcn_global_load_lds((const unsigned*)((const char*)(gbase) + (v2).a), (PG8_LAS unsigned*)(lds + (bufoff) + ldsw), 16, 0, 0); \
        __builtin_amdgcn_global_load_lds((const unsigned*)((const char*)(gbase) + (v2).b), (PG8_LAS unsigned*)(lds + (bufoff) + ldsw + 8192), 16, 0, 0); } while (0)
    const size_t kstep = (size_t)(BK * 2);
    const size_t hstepB = (size_t)HALF * g.ldb * 2;
    const size_t tstepB = 2 * hstepB;
    const unsigned ldsw = (unsigned)wid * 1024u;
    const int aoff0 = lds_byte(wr * 64 + fr, fq * 8), aoff1 = lds_byte(wr * 64 + fr, 32 + fq * 8), boff0 = lds_byte(wc * 32 + fr, fq * 8), boff1 = lds_byte(wc * 32 + fr, 32 + fq * 8);
#define PG8_SA(b, h) (((b) * 2 + (h)) * HTB)
#define PG8_SB(b, h) ((4 + (b) * 2 + (h)) * HTB)
#define PG8_STAGE(bufoff, gbase, voff) do { _Pragma("unroll") for (int _i = 0; _i < 2; ++_i) \
        __builtin_amdgcn_global_load_lds((const unsigned*)((const char*)(gbase) + (voff)[_i]), (PG8_LAS unsigned*)(lds + (bufoff) + ldsw + _i * 8192), 16, 0, 0); } while (0)
#define PG8_LDA(dst, b, h) do { _Pragma("unroll") for (int m = 0; m < 4; ++m) { const v4i_ lo_ = *(const PG8_LAS v4i_*)(lds + PG8_SA(b, h) + aoff0 + m * 2048), hi_ = *(const PG8_LAS v4i_*)(lds + PG8_SA(b, h) + aoff1 + m * 2048); dst[m] = __builtin_shufflevector(lo_, hi_, 0, 1, 2, 3, 4, 5, 6, 7); } } while (0)
#define PG8_LDB(dst, b, h) do { _Pragma("unroll") for (int n = 0; n < 2; ++n) { const v4i_ lo_ = *(const PG8_LAS v4i_*)(lds + PG8_SB(b, h) + boff0 + n * 2048), hi_ = *(const PG8_LAS v4i_*)(lds + PG8_SB(b, h) + boff1 + n * 2048); dst[n] = __builtin_shufflevector(lo_, hi_, 0, 1, 2, 3, 4, 5, 6, 7); } } while (0)
#define PG8_MMA(ai, bj, At, Bt) do { __builtin_amdgcn_s_setprio(1); _Pragma("unroll") for (int m = 0; m < 4; ++m) _Pragma("unroll") for (int n = 0; n < 2; ++n) \
        asm volatile("v_mfma_scale_f32_16x16x128_f8f6f4 %0, %1, %2, %0, %3, %3 op_sel_hi:[0,0,0]" : "+v"(acc[ai][bj][m][n]) : "v"(Bt[n]), "v"(At[m]), "v"(sc127)); __builtin_amdgcn_s_setprio(0); } while (0)
#define PG8_WAIT_V(n) asm volatile("s_waitcnt vmcnt(" #n ")" ::: "memory")
#define PG8_WAIT_L(n) asm volatile("s_waitcnt lgkmcnt(" #n ")" ::: "memory")
#define PG8_BAR __builtin_amdgcn_s_barrier()
#define PG8_SCHED __builtin_amdgcn_sched_barrier(0)
    Unit cur, nxt; int ui = 0;
    if (!S.next(0, cur)) return;
    f32x4 acc[2][2][4][2];
#pragma unroll
    for (int a = 0; a < 2; ++a)
#pragma unroll
        for (int b = 0; b < 2; ++b)
#pragma unroll
            for (int m = 0; m < 4; ++m)
#pragma unroll
                for (int n = 0; n < 2; ++n) acc[a][b][m][n] = (f32x4){0.f, 0.f, 0.f, 0.f};
    typedef int v4i_ __attribute__((ext_vector_type(4))); typedef int v8i_ __attribute__((ext_vector_type(8)));
    v8i_ At[4], B0[2], B1[2]; const int sc127 = 0x7f7f7f7f;
    PG8_GVOFF(vA0, vA1, 0);
    const char* cA = (const char*)g.A; const char* cB = (const char*)g.Bt + (size_t)cur.pb * tstepB;
    PG8_STAGE(PG8_SB(0, 0), cB, voffB); PG8_STAGE(PG8_SB(0, 1), cB + hstepB, voffB); PG8_STAGEA(PG8_SA(0, 0), cA, vA0); PG8_STAGEA(PG8_SA(0, 1), cA, vA1);
    if (wr == 1) PG8_BAR;
    PG8_WAIT_V(2); PG8_BAR;
    PG8_STAGE(PG8_SB(1, 0), cB + kstep, voffB); PG8_STAGEA(PG8_SA(1, 0), cA + kstep, vA0); PG8_STAGE(PG8_SB(1, 1), cB + hstepB + kstep, voffB);
    PG8_WAIT_V(6); PG8_BAR;
    for (;;) {
        const bool has_next = S.next(ui + 1, nxt);
        const char* nA = cA; const char* nB = has_next ? (const char*)g.Bt + (size_t)nxt.pb * tstepB : cB;
#pragma nounroll
        for (int t = 0; t < nt; t += 2) {
            const bool last = (t == nt - 2);
            const char* a1 = cA + (size_t)(t + 1) * kstep;
            const char* a2 = last ? nA : cA + (size_t)(t + 2) * kstep; const char* b2 = last ? nB : cB + (size_t)(t + 2) * kstep;
            const char* a3 = a2 + kstep; const char* b3 = b2 + kstep;
            V2 s0 = vA0, s1 = vA1; if (last && has_next) PG8_GVOFF(s0, s1, ui + 1);
            PG8_LDB(B0, 0, 0); PG8_LDB(B1, 0, 1); PG8_SCHED; PG8_LDA(At, 0, 0); PG8_STAGEA(PG8_SA(1, 1), a1, vA1);
            PG8_WAIT_V(8); PG8_WAIT_L(0); PG8_BAR; PG8_MMA(0, 0, At, B0); PG8_MMA(0, 1, At, B1); PG8_BAR; PG8_SCHED;
            PG8_LDA(At, 0, 1); PG8_STAGE(PG8_SB(0, 0), b2, voffB); PG8_STAGE(PG8_SB(0, 1), b2 + hstepB, voffB); PG8_STAGEA(PG8_SA(0, 0), a2, s0);
            PG8_WAIT_V(8); PG8_WAIT_L(0); PG8_BAR; PG8_MMA(1, 0, At, B0); PG8_MMA(1, 1, At, B1); PG8_BAR; PG8_SCHED;
            PG8_LDB(B0, 1, 0); PG8_LDB(B1, 1, 1); PG8_SCHED; PG8_LDA(At, 1, 0); PG8_STAGEA(PG8_SA(0, 1), a2, s1);
            PG8_WAIT_V(8); PG8_WAIT_L(0); PG8_BAR; PG8_MMA(0, 0, At, B0); PG8_MMA(0, 1, At, B1); PG8_BAR; PG8_SCHED;
            PG8_LDA(At, 1, 1); PG8_STAGE(PG8_SB(1, 0), b3, voffB); PG8_STAGE(PG8_SB(1, 1), b3 + hstepB, voffB); PG8_STAGEA(PG8_SA(1, 0), a3, s0);
            PG8_WAIT_V(8); PG8_WAIT_L(0); PG8_BAR; PG8_MMA(1, 0, At, B0); PG8_MMA(1, 1, At, B1); PG8_BAR; PG8_SCHED;
        }
        if (wr == 0) PG8_BAR;
        asm volatile("s_nop 15\n\ts_nop 15" ::: "memory");
        E(acc, cur, wr, wc, fr, fq);
#ifdef EPI_DUP
        if (__is_same(Epi, ::EpiBf16) || __is_same(Epi, ::EpiBf16S)) { asm volatile("" ::: "memory"); E(acc, cur, wr, wc, fr, fq); }
#endif
        if (!has_next) break;
#pragma unroll
        for (int a = 0; a < 2; ++a)
#pragma unroll
            for (int b = 0; b < 2; ++b)
#pragma unroll
                for (int m = 0; m < 4; ++m)
#pragma unroll
                    for (int n = 0; n < 2; ++n) acc[a][b][m][n] = (f32x4){0.f, 0.f, 0.f, 0.f};
        cur = nxt; cB = nB; ++ui; PG8_GVOFF(vA0, vA1, ui);
        if (wr == 1) PG8_BAR;
    }
    PG8_WAIT_V(0);
    PG8_BAR;
#undef PG8_GVOFF
#undef PG8_STAGEA
#undef PG8_SA
#undef PG8_SB
#undef PG8_STAGE
#undef PG8_LDA
#undef PG8_LDB
#undef PG8_MMA
#undef PG8_WAIT_V
#undef PG8_WAIT_L
#undef PG8_BAR
#undef PG8_SCHED
}
}

#define XB_TMO      128
#define XB_XCNT(j)  (256  + 64 * (j))
#define XB_XSUB(j)  (1280 + 64 * (j))
#define XB_XGEN(j)  (2304 + 64 * (j))
#define XB_TOP      3328
#define XB_TOPGEN   3392
#define XCD_BAR_WORDS 3456
#define XB_SPIN_CAP (1u << 21)
__device__ __forceinline__ unsigned xb_ld(unsigned* p)              { return __hip_atomic_load(p, __ATOMIC_RELAXED, __HIP_MEMORY_SCOPE_AGENT); }
__device__ __forceinline__ unsigned xb_add(unsigned* p, unsigned v) { return __hip_atomic_fetch_add(p, v, __ATOMIC_RELAXED, __HIP_MEMORY_SCOPE_AGENT); }
__device__ __forceinline__ unsigned xb_xcc_id() { return (unsigned)__builtin_amdgcn_s_getreg((3 << 11) | 20) & 0xFu; }
#define XB_SPIN(cond, bar) do { unsigned _sp = 0; while (cond) { __builtin_amdgcn_s_sleep(1); \
    if ((++_sp & 255u) == 0u) { if (xb_ld(&(bar)[XB_TMO])) break; if (_sp > XB_SPIN_CAP) { atomicAdd(&(bar)[XB_TMO], 1u); break; } } } } while (0)
struct XcdBarrier { unsigned* bar; unsigned x; volatile LAS unsigned* st; };
__device__ __forceinline__ XcdBarrier xcd_barrier_post(unsigned* bar, volatile LAS unsigned* st) {
    XcdBarrier b; b.bar = bar; b.x = xb_xcc_id(); b.st = st;
    if (threadIdx.x == 0) (void)xb_add(&bar[XB_XCNT(b.x)], 1u);
    return b;
}
__device__ __forceinline__ void xcd_barrier_complete(unsigned* bar, unsigned x, unsigned& nloc, unsigned& nx) {
    const unsigned G = gridDim.x * gridDim.y * gridDim.z;
    unsigned sum, cnt, mine, sp = 0u;
    for (;;) {
        sum = 0u; cnt = 0u; mine = 0u;
#pragma unroll
        for (unsigned j = 0; j < 16; ++j) { const unsigned c = xb_ld(&bar[XB_XCNT(j)]); sum += c; cnt += (c > 0u) ? 1u : 0u; mine = (j == x) ? c : mine; }
        if (sum == G) break;
        __builtin_amdgcn_s_sleep(1);
        if ((++sp & 255u) == 0u) { if (xb_ld(&bar[XB_TMO])) break; if (sp > XB_SPIN_CAP) { atomicAdd(&bar[XB_TMO], 1u); break; } }
    }
    nloc = mine > 0u ? mine : 1u; nx = cnt > 0u ? cnt : 1u;
}
template <bool FIRST>
__device__ __forceinline__ void xcd_barrier_t(const XcdBarrier& b) {
    asm volatile("s_waitcnt vmcnt(0)" ::: "memory");
    __syncthreads();
    if (threadIdx.x == 0) {
        unsigned* bar = b.bar;
        __builtin_amdgcn_s_waitcnt(0);
        unsigned nloc = b.st[0], nx = b.st[1];
        if (FIRST) { if (nloc == 0u) { xcd_barrier_complete(bar, b.x, nloc, nx); b.st[0] = nloc; b.st[1] = nx; } }
        const unsigned old = xb_add(&bar[XB_XSUB(b.x)], 1u);
        const unsigned gen = old / nloc;
        if (old + 1u == (gen + 1u) * nloc) {
            __builtin_amdgcn_fence(__ATOMIC_RELEASE, "agent");
            asm volatile("s_waitcnt vmcnt(0)" ::: "memory");
            const unsigned og = xb_add(&bar[XB_TOP], 1u);
            const unsigned tg = og / nx;
            asm volatile("buffer_inv sc1" ::: "memory");
            if (og + 1u == (tg + 1u) * nx) xb_add(&bar[XB_TOPGEN], 1u);
            else XB_SPIN(xb_ld(&bar[XB_TOPGEN]) == tg, bar);
            asm volatile("s_waitcnt vmcnt(0)" ::: "memory");
            xb_add(&bar[XB_XGEN(b.x)], 1u);
            asm volatile("s_waitcnt vmcnt(0)" ::: "memory");
        } else {
            asm volatile("buffer_inv sc1" ::: "memory");
            XB_SPIN(xb_ld(&bar[XB_XGEN(b.x)]) == gen, bar);
            asm volatile("s_waitcnt vmcnt(0)" ::: "memory");
        }
    }
    __syncthreads();
}
#define EPI_LOOP_BEGIN \
    const int row0 = u.pm * 256 + wr * 64 + fr, col0 = u.pn * 256 + wc * 32 + 8 * fq; \
    _Pragma("unroll") for (int ai = 0; ai < 2; ++ai) _Pragma("unroll") for (int m = 0; m < 4; ++m) { const int row = row0 + ai * 128 + m * 16; \
    _Pragma("unroll") for (int bj = 0; bj < 2; ++bj) { const int col = col0 + bj * 128; const f32x4 v0 = acc[ai][bj][m][0], v1 = acc[ai][bj][m][1];
#define EPI_LOOP_END } }
typedef const f32x4 (&AccRef)[2][2][4][2];
__device__ __forceinline__ u32x4 pack8(f32x4 v0, f32x4 v1) { u32x4 w; w.x = cvt_pk_bf16(v0[0], v0[1]); w.y = cvt_pk_bf16(v0[2], v0[3]); w.z = cvt_pk_bf16(v1[0], v1[1]); w.w = cvt_pk_bf16(v1[2], v1[3]); return w; }
__device__ __forceinline__ f32x4 silu4(f32x4 v) { return (f32x4){siluf_(v[0]), siluf_(v[1]), siluf_(v[2]), siluf_(v[3])}; }

struct EpiBf16 {
    bf16* O; int ldc;
    __device__ __forceinline__ void operator()(AccRef acc, const pg8::Unit& u, int wr, int wc, int fr, int fq) const {
        EPI_LOOP_BEGIN *(u32x4*)(O + (size_t)row * ldc + col) = pack8(v0, v1); EPI_LOOP_END
    }
};
struct EpiResid {
    const float* XF; bf16* XB;
    __device__ __forceinline__ void operator()(AccRef acc, const pg8::Unit& u, int wr, int wc, int fr, int fq) const {
        const int row0 = u.pm * 256 + wr * 64 + fr, col0 = u.pn * 256 + wc * 32 + 8 * fq;
#pragma unroll
        for (int ai = 0; ai < 2; ++ai) {
            if (XF) { f32x4 ra[4][2][2];
#pragma unroll
                for (int m = 0; m < 4; ++m)
#pragma unroll
                    for (int bj = 0; bj < 2; ++bj) { const float* p = XF + (size_t)(row0 + ai * 128 + m * 16) * DM + col0 + bj * 128; ra[m][bj][0] = *(const f32x4*)p; ra[m][bj][1] = *(const f32x4*)(p + 4); }
#pragma unroll
                for (int m = 0; m < 4; ++m)
#pragma unroll
                    for (int bj = 0; bj < 2; ++bj) *(u32x4*)(XB + (size_t)(row0 + ai * 128 + m * 16) * DM + col0 + bj * 128) = pack8(ra[m][bj][0] + acc[ai][bj][m][0], ra[m][bj][1] + acc[ai][bj][m][1]); }
            else { u32x4 rb[4][2];
#pragma unroll
                for (int m = 0; m < 4; ++m)
#pragma unroll
                    for (int bj = 0; bj < 2; ++bj) rb[m][bj] = *(const u32x4*)(XB + (size_t)(row0 + ai * 128 + m * 16) * DM + col0 + bj * 128);
#pragma unroll
                for (int m = 0; m < 4; ++m)
#pragma unroll
                    for (int bj = 0; bj < 2; ++bj) { const u32x4 t = rb[m][bj]; const f32x4 a = (f32x4){bflo(t.x), bfhi(t.x), bflo(t.y), bfhi(t.y)}, b = (f32x4){bflo(t.z), bfhi(t.z), bflo(t.w), bfhi(t.w)};
                        *(u32x4*)(XB + (size_t)(row0 + ai * 128 + m * 16) * DM + col0 + bj * 128) = pack8(a + acc[ai][bj][m][0], b + acc[ai][bj][m][1]); } }
        }
    }
};
struct EpiF32 {
    float* C; int ldc;
    __device__ __forceinline__ void operator()(AccRef acc, const pg8::Unit& u, int wr, int wc, int fr, int fq) const {
        EPI_LOOP_BEGIN float* p = C + (size_t)row * ldc + col; *(f32x4*)p = v0; *(f32x4*)(p + 4) = v1; EPI_LOOP_END
    }
};
struct EpiEvenIn {
    bf16* QS; bf16* ZF; bf16* ZB; bf16* VI; bf16* GA; bf16* UP;
    __device__ __forceinline__ void operator()(AccRef acc, const pg8::Unit& u, int wr, int wc, int fr, int fq) const {
        const int sec = u.pn >> 1;
        EPI_LOOP_BEGIN
            const int cc = col & 511;
            if (sec == 0) *(u32x4*)(QS + (size_t)row * 512 + cc) = pack8(silu4(v0), silu4(v1));
            else if (sec == 1) *(u32x4*)(ZF + (size_t)row * 512 + cc) = pack8(v0, v1);
            else if (sec == 2) *(u32x4*)(ZB + (size_t)row * 512 + cc) = pack8(v0, v1);
            else if (sec == 3) *(u32x4*)(VI + (size_t)row * 512 + cc) = pack8(v0, v1);
            else if (sec == 4) *(u32x4*)(GA + (size_t)row * 512 + cc) = pack8(silu4(v0), silu4(v1));
            else *(u32x4*)(UP + ((size_t)(cc >> 4) * 512 + (row >> 6)) * 1280 + (row & 63) * 16 + (cc & 15)) = pack8(v0, v1);
        EPI_LOOP_END
    }
};
struct EpiS5Main {
    bf16* YG;
    __device__ __forceinline__ void operator()(AccRef acc, const pg8::Unit& u, int wr, int wc, int fr, int fq) const {
        EPI_LOOP_BEGIN
            const f32x4 g0 = (f32x4){gelu_tanh(v0[0]), gelu_tanh(v0[1]), gelu_tanh(v0[2]), gelu_tanh(v0[3])}, g1 = (f32x4){gelu_tanh(v1[0]), gelu_tanh(v1[1]), gelu_tanh(v1[2]), gelu_tanh(v1[3])};
            *(u32x4*)(YG + ((size_t)(row & 511) * 64 + (col >> 4)) * 512 + (row >> 9) * 16 + (col & 15)) = pack8(g0, g1);
        EPI_LOOP_END
    }
};
struct EpiGlu {
    const bf16* YG; const float* bias; bf16* MIX;
    __device__ __forceinline__ void operator()(AccRef acc, const pg8::Unit& u, int wr, int wc, int fr, int fq) const {
        const int row0_ = u.pm * 256 + wr * 64 + fr, col0_ = u.pn * 256 + wc * 32 + 8 * fq;
        f32x4 bs[2][2]; u32x4 yall[2][4][2];
#pragma unroll
        for (int bj = 0; bj < 2; ++bj) { bs[bj][0] = *(const f32x4*)(bias + col0_ + bj * 128); bs[bj][1] = *(const f32x4*)(bias + col0_ + bj * 128 + 4); }
#pragma unroll
        for (int ai = 0; ai < 2; ++ai)
#pragma unroll
            for (int m = 0; m < 4; ++m)
#pragma unroll
                for (int bj = 0; bj < 2; ++bj) yall[ai][m][bj] = *(const u32x4*)(YG + (size_t)(row0_ + ai * 128 + m * 16) * 512 + col0_ + bj * 128);
        EPI_LOOP_BEGIN
            const u32x4 yv = yall[ai][m][bj]; const f32x4 b0 = bs[bj][0], b1 = bs[bj][1];
            const f32x4 t0 = v0 + b0, t1 = v1 + b1;
            const f32x4 o0 = (f32x4){bflo(yv.x) * sigmoidf_(t0[0]), bfhi(yv.x) * sigmoidf_(t0[1]), bflo(yv.y) * sigmoidf_(t0[2]), bfhi(yv.y) * sigmoidf_(t0[3])};
            const f32x4 o1 = (f32x4){bflo(yv.z) * sigmoidf_(t1[0]), bfhi(yv.z) * sigmoidf_(t1[1]), bflo(yv.w) * sigmoidf_(t1[2]), bfhi(yv.w) * sigmoidf_(t1[3])};
            f32x4 q0_ = o0, q1_ = o1; for (int e_ = 0; e_ < 4; ++e_) { q0_[e_] = QM(q0_[e_]); q1_[e_] = QM(q1_[e_]); }
            *(u32x4*)(MIX + (size_t)row * DM + 512 + col) = pack8(q0_, q1_);
        EPI_LOOP_END
    }
};
struct EpiMoe1 {
    unsigned char* HID8; float sc;
    __device__ __forceinline__ void operator()(AccRef acc, const pg8::Unit& u, int wr, int wc, int fr, int fq) const {
        const int row0 = u.pm * 256 + wr * 64 + fr, col0 = u.pn * 128 + wc * 32 + 8 * fq;
#pragma unroll
        for (int ai = 0; ai < 2; ++ai)
#pragma unroll
            for (int m = 0; m < 4; ++m) { const int row = row0 + ai * 128 + m * 16;
                const f32x4 ag0 = acc[ai][0][m][0], ag1 = acc[ai][0][m][1], au0 = acc[ai][1][m][0], au1 = acc[ai][1][m][1];
                const float kt = -LOG2E * sc, kc = 0.25f / (sc * sc);
                const f32x4 t0 = ag0 * kt, t1 = ag1 * kt;
                const f32x4 e0 = (f32x4){__builtin_amdgcn_exp2f(t0[0]), __builtin_amdgcn_exp2f(t0[1]), __builtin_amdgcn_exp2f(t0[2]), __builtin_amdgcn_exp2f(t0[3])}, e1 = (f32x4){__builtin_amdgcn_exp2f(t1[0]), __builtin_amdgcn_exp2f(t1[1]), __builtin_amdgcn_exp2f(t1[2]), __builtin_amdgcn_exp2f(t1[3])};
                const f32x4 d0 = e0 * kc + kc, d1 = e1 * kc + kc;
                const f32x4 r0 = (f32x4){fast_rcp(d0[0]), fast_rcp(d0[1]), fast_rcp(d0[2]), fast_rcp(d0[3])}, r1 = (f32x4){fast_rcp(d1[0]), fast_rcp(d1[1]), fast_rcp(d1[2]), fast_rcp(d1[3])};
                const f32x4 h0 = (ag0 * au0) * r0, h1 = (ag1 * au1) * r1; u32x2 o; o.x = pk_fp8x4(h0[0], h0[1], h0[2], h0[3]); o.y = pk_fp8x4(h1[0], h1[1], h1[2], h1[3]);
                *(u32x2*)(HID8 + (size_t)row * FF + col0) = o; }
    }
};
struct EpiBf16S {
    bf16* O; int ldc; float sc;
    __device__ __forceinline__ void operator()(AccRef acc, const pg8::Unit& u, int wr, int wc, int fr, int fq) const {
        EPI_LOOP_BEGIN *(u32x4*)(O + (size_t)row * ldc + col) = pack8(v0 * sc, v1 * sc); EPI_LOOP_END
    }
};
struct EpiFp8S {
    unsigned char* O; int ldc; float sc;
    __device__ __forceinline__ void operator()(AccRef acc, const pg8::Unit& u, int wr, int wc, int fr, int fq) const {
        EPI_LOOP_BEGIN u32x2 o; f32x4 c0 = v0 * sc, c1 = v1 * sc;
            for (int e_ = 0; e_ < 4; ++e_) { c0[e_] = __builtin_amdgcn_fmed3f(c0[e_], -448.f, 448.f); c1[e_] = __builtin_amdgcn_fmed3f(c1[e_], -448.f, 448.f); }
            o.x = pk_fp8x4(c0[0], c0[1], c0[2], c0[3]); o.y = pk_fp8x4(c1[0], c1[1], c1[2], c1[3]); *(u32x2*)(O + (size_t)row * ldc + col) = o; EPI_LOOP_END
    }
};
struct EpiMoe2 {
    bf16* YS; const float* GATE;
    __device__ __forceinline__ void operator()(AccRef acc, const pg8::Unit& u, int wr, int wc, int fr, int fq) const {
        const float* gp = GATE + u.pm * 256 + wr * 64 + fr;
        EPI_LOOP_BEGIN const float gt = gp[ai * 128 + m * 16]; *(u32x4*)(YS + (size_t)row * DM + col) = pack8(v0 * gt, v1 * gt); EPI_LOOP_END
    }
};
constexpr size_t MiB = 1u << 20;
constexpr size_t al(size_t x) { return (x + 4095) & ~(size_t)4095; }
constexpr size_t WS_CTL = 0, CTL_BYTES = 64 * 1024;
constexpr size_t WS_WEI = 1 * MiB;
constexpr size_t WS_WOI = WS_WEI + al((size_t)2 * 3072 * 1024 * 2);
constexpr size_t WS_WEO = WS_WOI + al((size_t)2 * 3584 * 1024 * 2);
constexpr size_t WS_WOO = WS_WEO + al((size_t)2 * 1024 * 1024 * 2);
constexpr size_t WS_WGL = WS_WOO + al((size_t)2 * 1024 * 1024 * 2);
constexpr size_t WS_LB  = WS_WGL + al((size_t)2 * 512 * 512 * 2);
constexpr size_t WS_KTAB = WS_LB + al(2 * 2 * 512 * 4);
constexpr size_t WS_TW  = WS_KTAB + al((size_t)2 * 32 * 2 * 64 * 256 * 4);
constexpr size_t WS_SV  = WS_TW + al((size_t)2 * 32 * 1024 * 1280 * 2);
constexpr size_t WS_WGU = WS_SV + al((size_t)2 * 32 * 256 * 1024 * 2);
constexpr size_t WS_WD  = WS_WGU + al((size_t)16 * 4096 * 1024 * 2);
constexpr size_t WS_HN  = WS_WD + al((size_t)16 * 1024 * 2048 * 2);
constexpr size_t WS_MIX = WS_HN + al((size_t)T * DM * 2);
constexpr size_t WS_R   = WS_MIX + al((size_t)T * DM * 2);
constexpr size_t R_QD  = 0;
constexpr size_t R_KDT = R_QD + (size_t)2 * T * 512 * 2;
constexpr size_t R_VAL = R_KDT + (size_t)2 * T * 512 * 2;
constexpr size_t R_KC  = R_VAL + (size_t)2 * T * 512 * 2;
constexpr size_t R_AT  = R_KC + (size_t)2 * T * 512 * 2;
constexpr size_t R_DEC = R_AT + (size_t)32 * 128 * 4096 * 2;
constexpr size_t R_OS  = R_DEC + (size_t)32 * 128 * 128 * 4;
constexpr size_t R_SCAN_END = R_OS + (size_t)2 * T * 512 * 4;
constexpr size_t R_QS = R_SCAN_END;
constexpr size_t R_ZF = R_QS + (size_t)T * 512 * 2;
constexpr size_t R_ZB = R_ZF + (size_t)T * 512 * 4;
constexpr size_t R_VI = R_ZB + (size_t)T * 512 * 4;
constexpr size_t R_GA = R_VI + (size_t)T * 512 * 2;
constexpr size_t R_UP = R_GA + (size_t)T * 512 * 2;
constexpr size_t R_EB = R_UP + (size_t)16384 * 1280 * 2;
constexpr size_t R_YG = R_EB + (size_t)16384 * 256 * 4;
constexpr size_t R_EVEN_END = R_YG + (size_t)T * 512 * 2;
constexpr size_t R_PO = R_SCAN_END;
constexpr size_t R_AB = R_PO + (size_t)T * 3584 * 2;
constexpr size_t R_AQ = R_AB + (size_t)T * 16 * 4;
constexpr size_t R_AK = R_AQ + (size_t)T * 512 * 2;
constexpr size_t R_AVT = R_AK + (size_t)T * 512 * 2;
constexpr size_t R_AO = R_AVT + (size_t)T * 512 * 2;
constexpr size_t R_GQ = R_AO + (size_t)T * 1024 * 4;
constexpr size_t R_GK = R_GQ + (size_t)T * 512 * 2;
constexpr size_t R_GV = R_GK + (size_t)T * 512 * 2;
constexpr size_t R_GG = R_GV + (size_t)T * 512 * 2;
constexpr size_t R_GB = R_GG + (size_t)T * 8 * 4;
constexpr size_t R_ODD_END = R_GB + (size_t)T * 8 * 4;
constexpr size_t R_AFF = 0;
constexpr size_t R_SEL = R_AFF + (size_t)NB * NE * SEQ * 4;
constexpr size_t R_IDX = R_SEL + (size_t)T * 16 * 4;
constexpr size_t R_GATE = R_IDX + (size_t)NSLOT * 4;
constexpr size_t R_XG = R_GATE + (size_t)NSLOT * 4;
constexpr size_t R_HID = R_XG + (size_t)NSLOT * DM * 2;
constexpr size_t R_YS = R_HID + (size_t)NSLOT * FF * 2;
constexpr size_t R_MOE_END = R_YS + (size_t)NSLOT * DM * 2;
constexpr size_t R_MAX1 = R_EVEN_END > R_ODD_END ? R_EVEN_END : R_ODD_END;
constexpr size_t R_MAX = R_MAX1 > R_MOE_END ? R_MAX1 : R_MOE_END;
constexpr size_t WS_XB  = WS_R + R_MAX;
constexpr size_t WS_END = WS_XB + al((size_t)T * DM * 2);

constexpr int RING_BYTES = 147456, MISC_OFF = RING_BYTES + 320, LDS_BYTES = 151552;

struct Args { const float* in[32]; float* out; unsigned char* ws; };
enum { I_X = 0, I_MIXN, I_FFNN, I_EVWIN, I_EVWOUT, I_ALB, I_AOUTN, I_S5LRE, I_S5LIM, I_S5LS, I_S5BRE, I_S5BIM, I_S5CRE, I_S5CIM, I_S5D, I_S5GW, I_S5GB,
       I_ODWIN, I_ODWOUT, I_CQN, I_CKN, I_CLAM, I_COUTN, I_RELB, I_DCONV, I_DALOG, I_DDTB, I_DOUTN, I_ROUTER, I_WGATE, I_WUP, I_WDOWN };

constexpr int CW_Q = 4096;
__device__ __forceinline__ int wq_next(unsigned* ctr, volatile LAS unsigned* slot, int tid) {
    lds_barrier();
    if (tid == 0) *slot = __hip_atomic_fetch_add(ctr, 1u, __ATOMIC_RELAXED, __HIP_MEMORY_SCOPE_AGENT);
    lds_barrier();
    return (int)*slot;
}
__device__ __forceinline__ int wq_next_xcd(unsigned* ctr8, int xcd, int nper, volatile LAS unsigned* slot, int tid) {
    lds_barrier();
    if (tid == 0) { int r = -1;
        for (int k = 0; k < 8; ++k) { const int q = (xcd + k) & 7; const unsigned i = __hip_atomic_fetch_add(ctr8 + 64 * q, 1u, __ATOMIC_RELAXED, __HIP_MEMORY_SCOPE_AGENT); if ((int)i < nper) { r = q * nper + (int)i; break; } }
        *slot = (unsigned)r; }
    lds_barrier();
    return (int)*slot;
}
__device__ __forceinline__ void tr_item(const float* W, int ldw, bf16* WT, int Kd, int k0, int nsrc, int ndst, LAS float* scr, int lane, float qs = 0.f) {
    float rv[32];
    const float* wp = W + (size_t)(k0 + (lane >> 5)) * ldw + nsrc + (lane & 31);
#pragma unroll
    for (int i = 0; i < 32; ++i) rv[i] = wp[(size_t)(2 * i) * ldw];
#pragma unroll
    for (int i = 0; i < 32; ++i) scr[(2 * i + (lane >> 5)) * 33 + (lane & 31)] = rv[i];
    LDS_WAIT(); asm volatile("" ::: "memory");
    const int c = lane & 7;
#pragma unroll
    for (int j = 0; j < 4; ++j) { const int n = (lane >> 3) + 8 * j; const LAS float* s = scr + (8 * c) * 33 + n;
        float t_[8];
#pragma unroll
        for (int i_ = 0; i_ < 8; ++i_) { t_[i_] = s[i_ * 33]; if (qs != 0.f) t_[i_] = q8(t_[i_], qs); }
        u32x4 o; o.x = cvt_pk_bf16(t_[0], t_[1]); o.y = cvt_pk_bf16(t_[2], t_[3]); o.z = cvt_pk_bf16(t_[4], t_[5]); o.w = cvt_pk_bf16(t_[6], t_[7]);
        *(u32x4*)(WT + (size_t)(ndst + n) * Kd + k0 + 8 * c) = o; }
    LDS_WAIT(); asm volatile("" ::: "memory");
}

__device__ __forceinline__ void tr_item64(const float* W, int ldw, bf16* WT, int Kd, int k0, int nsrc, int ndst, LAS float* scr, int lane) {
    float rv[64];
    const float* wp = W + (size_t)k0 * ldw + nsrc + lane;
#pragma unroll
    for (int i = 0; i < 64; ++i) rv[i] = wp[(size_t)i * ldw];
#pragma unroll
    for (int i = 0; i < 64; ++i) scr[i * 65 + lane] = rv[i];
    LDS_WAIT(); asm volatile("" ::: "memory");
    const int c = lane & 7;
#pragma unroll
    for (int j = 0; j < 8; ++j) { const int n = (lane >> 3) + 8 * j; const LAS float* s = scr + (8 * c) * 65 + n;
        u32x4 o; o.x = cvt_pk_bf16(s[0 * 65], s[1 * 65]); o.y = cvt_pk_bf16(s[2 * 65], s[3 * 65]); o.z = cvt_pk_bf16(s[4 * 65], s[5 * 65]); o.w = cvt_pk_bf16(s[6 * 65], s[7 * 65]);
        *(u32x4*)(WT + (size_t)(ndst + n) * Kd + k0 + 8 * c) = o; }
    LDS_WAIT(); asm volatile("" ::: "memory");
}
struct Cplx { float re, im; };
__device__ __forceinline__ Cplx cmul(Cplx a, Cplx b) { return Cplx{a.re * b.re - a.im * b.im, a.re * b.im + a.im * b.re}; }
__device__ __forceinline__ void s5_disc(const Args& A, int jd, int g, int n, Cplx& th, Cplx& f) {
    const int ix = (jd * 32 + g) * 64 + n;
    const float lre = A.in[I_S5LRE][ix], lim = A.in[I_S5LIM][ix], step = expf(A.in[I_S5LS][jd * 32 + g]);
    th.re = lre * step; th.im = lim * step;
    const float mag = expf(th.re); float sn, cs; sincosf(th.im, &sn, &cs);
    const float are = mag * cs, aim = mag * sn, den = lre * lre + lim * lim;
    f.re = ((are - 1.f) * lre + aim * lim) / den; f.im = (aim * lre - (are - 1.f) * lim) / den;
}
__device__ __forceinline__ Cplx s5_pow(Cplx th, float m) { const float mag = expf(m * th.re); float sn, cs; sincosf(m * th.im, &sn, &cs); return Cplx{mag * cs, mag * sn}; }

__device__ __forceinline__ void s5_ktab_item(const Args& A, float* KTAB, int item, LAS float* scr, int lane) {
    const int lag = item & 63, g = (item >> 6) & 31, jd = item >> 11;
    Cplx th, f; s5_disc(A, jd, g, lane, th, f);
    const Cplx w = cmul(s5_pow(th, (float)lag), f);
    scr[lane] = w.re; scr[64 + lane] = w.im;
    LDS_WAIT(); asm volatile("" ::: "memory");
    const float* cre = A.in[I_S5CRE] + (size_t)(jd * 32 + g) * 1024; const float* cim = A.in[I_S5CIM] + (size_t)(jd * 32 + g) * 1024;
    const float* bre = A.in[I_S5BRE] + (size_t)(jd * 32 + g) * 1024; const float* bim = A.in[I_S5BIM] + (size_t)(jd * 32 + g) * 1024;
#pragma unroll
    for (int i = 0; i < 4; ++i) { const int e = lane + 64 * i, p = e >> 4, pp = e & 15; float acc = 0.f;
        for (int n = 0; n < 64; ++n) { const float wr_ = scr[n], wi_ = scr[64 + n], cr = cre[p * 64 + n], ci = cim[p * 64 + n];
            const float gr = cr * wr_ - ci * wi_, gi = cr * wi_ + ci * wr_; acc += gr * bre[n * 16 + pp] - gi * bim[n * 16 + pp]; }
        KTAB[((size_t)item) * 256 + e] = acc; }
    LDS_WAIT(); asm volatile("" ::: "memory");
}
__device__ __forceinline__ void s5_tw_unit(const Args& A, const float* KTAB, bf16* TW, int unit, int tid, LAS float* scr) {
    const int i = unit & 63, g = (unit >> 6) & 31, j = unit >> 11;
    __syncthreads();
    if (tid < 128) { const int dir = tid >> 6, n = tid & 63; Cplx th, f; s5_disc(A, j * 2 + dir, g, n, th, f); const Cplx ap = s5_pow(th, dir == 0 ? (float)(i + 1) : (float)(64 - i)); scr[tid * 2] = ap.re; scr[tid * 2 + 1] = ap.im; }
    __syncthreads();
#pragma unroll
    for (int it = tid; it < 16 * 160; it += 512) { const int p = it / 160, oc = it % 160, k0 = oc * 8; float v[8];
        if (k0 < 1024) { const int jp = k0 >> 4, pp0 = k0 & 15, lag = i - jp;
            if (lag != 0) { const int dir = lag > 0 ? 0 : 1, al_ = lag > 0 ? lag : -lag; const float* kt = KTAB + ((size_t)(((j * 2 + dir) * 32 + g) * 64 + al_)) * 256 + p * 16 + pp0;
#pragma unroll
                for (int e = 0; e < 8; ++e) v[e] = kt[e]; }
            else { const float* k0p = KTAB + ((size_t)(((j * 2 + 0) * 32 + g) * 64)) * 256 + p * 16 + pp0; const float* k1p = KTAB + ((size_t)(((j * 2 + 1) * 32 + g) * 64)) * 256 + p * 16 + pp0;
#pragma unroll
                for (int e = 0; e < 8; ++e) v[e] = k0p[e] + k1p[e] + ((pp0 + e == p) ? A.in[I_S5D][j * 512 + g * 16 + p] : 0.f); }
        } else { const int c0 = k0 - 1024, q = c0 >> 6, dir = q >> 1, jd = j * 2 + dir;
#pragma unroll
            for (int e = 0; e < 8; ++e) { const int n = (c0 & 63) + e; const Cplx ap = Cplx{scr[(dir * 64 + n) * 2], scr[(dir * 64 + n) * 2 + 1]};
                const int cix = ((jd * 32 + g) * 16 + p) * 64 + n; const Cplx G = cmul(Cplx{A.in[I_S5CRE][cix], A.in[I_S5CIM][cix]}, ap);
                v[e] = (q & 1) ? -G.im : G.re; } }
        u32x4 o; o.x = cvt_pk_bf16(v[0], v[1]); o.y = cvt_pk_bf16(v[2], v[3]); o.z = cvt_pk_bf16(v[4], v[5]); o.w = cvt_pk_bf16(v[6], v[7]);
        *(u32x4*)(TW + ((size_t)((j * 32 + g) * 1024 + i * 16 + p)) * 1280 + k0) = o; }
}
__device__ __forceinline__ void s5_sv_unit(const Args& A, bf16* SV, int unit, int tid) {
    const int q = unit & 3, g = (unit >> 2) & 31, j = unit >> 7, dir = q >> 1, jd = j * 2 + dir;
    for (int it = tid; it < 64 * 128; it += 512) { const int n = it >> 7, oc = it & 127, jp = oc >> 1, pp0 = (oc & 1) * 8;
        Cplx th, f; s5_disc(A, jd, g, n, th, f); const Cplx w = cmul(s5_pow(th, dir == 0 ? (float)(63 - jp) : (float)jp), f);
        const int bix = ((jd * 32 + g) * 64 + n) * 16 + pp0; float v[8];
#pragma unroll
        for (int e = 0; e < 8; ++e) { const Cplx bb = cmul(w, Cplx{A.in[I_S5BRE][bix + e], A.in[I_S5BIM][bix + e]}); v[e] = (q & 1) ? bb.im : bb.re; }
        u32x4 o; o.x = cvt_pk_bf16(v[0], v[1]); o.y = cvt_pk_bf16(v[2], v[3]); o.z = cvt_pk_bf16(v[4], v[5]); o.w = cvt_pk_bf16(v[6], v[7]);
        *(u32x4*)(SV + ((size_t)((j * 32 + g) * 256 + q * 64 + n)) * 1024 + jp * 16 + pp0) = o; }
}
__device__ __forceinline__ void s5_carry(const Args& A, int j, const float* EB, bf16* UP, int gtid) {
    const int n = gtid & 63, dir = (gtid >> 6) & 1, g = (gtid >> 7) & 31, b = gtid >> 12;
    Cplx th, f; s5_disc(A, j * 2 + dir, g, n, th, f); const Cplx a64 = s5_pow(th, 64.f);
    Cplx x{0.f, 0.f};
#pragma nounroll
    for (int c0 = 0; c0 < NCH; c0 += 16) {
        float er[16], ei[16];
#pragma unroll
        for (int u = 0; u < 16; ++u) { const int cc = c0 + u, c = dir == 0 ? cc : NCH - 1 - cc; const size_t row = (size_t)g * 512 + b * NCH + c;
            er[u] = EB[row * 256 + dir * 128 + n]; ei[u] = EB[row * 256 + dir * 128 + 64 + n]; }
#pragma unroll
        for (int u = 0; u < 16; ++u) { const int cc = c0 + u, c = dir == 0 ? cc : NCH - 1 - cc; const size_t row = (size_t)g * 512 + b * NCH + c;
            UP[row * 1280 + 1024 + dir * 128 + n] = f2bf(x.re); UP[row * 1280 + 1024 + dir * 128 + 64 + n] = f2bf(x.im);
            const Cplx ax = cmul(a64, x); x.re = ax.re + er[u]; x.im = ax.im + ei[u]; } }
}
__device__ __forceinline__ void norm_fill_w(LAS float* Wt, const float* W16, int ldw, int tid) {
    {   float wv[32];
#pragma unroll
        for (int i = 0; i < 32; ++i) { const int idx = tid + 512 * i, k = idx >> 4, e = idx & 15; wv[i] = W16[(size_t)k * ldw + e]; }
#pragma unroll
        for (int i = 0; i < 32; ++i) { const int idx = tid + 512 * i, k = idx >> 4, e = idx & 15; Wt[e * 1028 + k] = wv[i]; } }
}
__device__ __forceinline__ void router_finish(const float (&a16)[16], int mode, float* OUT16, int row, int lane) {
#define RS_DPP(x, ctl) __int_as_float(__builtin_amdgcn_update_dpp(0, __float_as_int(x), ctl, 0xf, 0xf, true))
#define RS_SWZ(x, pat) __int_as_float(__builtin_amdgcn_ds_swizzle(__float_as_int(x), pat))
    const bool b0 = (lane & 1) != 0, b1 = (lane & 2) != 0, b2 = (lane & 4) != 0, b3 = (lane & 8) != 0;
        float r8[8], r4[4], r2[2];
#pragma unroll
        for (int i = 0; i < 8; ++i) { const float keep = b0 ? a16[i + 8] : a16[i], send = b0 ? a16[i] : a16[i + 8]; r8[i] = keep + RS_DPP(send, 0xB1); }
#pragma unroll
        for (int i = 0; i < 4; ++i) { const float keep = b1 ? r8[i + 4] : r8[i], send = b1 ? r8[i] : r8[i + 4]; r4[i] = keep + RS_DPP(send, 0x4E); }
#pragma unroll
        for (int i = 0; i < 2; ++i) { const float keep = b2 ? r4[i + 2] : r4[i], send = b2 ? r4[i] : r4[i + 2]; r2[i] = keep + RS_SWZ(send, 0x101F); }
        float lgv; { const float keep = b3 ? r2[1] : r2[0], send = b3 ? r2[0] : r2[1]; lgv = keep + RS_SWZ(send, 0x201F); }
        lgv += RS_SWZ(lgv, 0x401F);
        lgv += shfl_xor32(lgv, lane);
        const int eidx = ((lane & 1) << 3) | ((lane & 2) << 1) | ((lane & 4) >> 1) | ((lane & 8) >> 3);
        float outv = lgv;
        if (mode == 1) {
            float mx = lgv; mx = fmaxf(mx, RS_DPP(mx, 0xB1)); mx = fmaxf(mx, RS_DPP(mx, 0x4E)); mx = fmaxf(mx, RS_DPP(mx, 0x141)); mx = fmaxf(mx, RS_DPP(mx, 0x140));
            const float pe = fast_exp(lgv - mx); float sm = pe; sm += RS_DPP(sm, 0xB1); sm += RS_DPP(sm, 0x4E); sm += RS_DPP(sm, 0x141); sm += RS_DPP(sm, 0x140);
            outv = pe * (1.f / sm); }
#undef RS_DPP
#undef RS_SWZ
        if (lane < 16) { if (mode == 1) { const int b = row >> 13, l = row & (SEQ - 1); OUT16[((size_t)(b * NE + eidx)) * SEQ + l] = outv; } else OUT16[(size_t)row * 16 + eidx] = outv; }
}
__device__ __forceinline__ void row_norm_tail(f32x4 (&v)[4], const f32x4 (&gn)[4], bf16* HN, int mode, const LAS float* Wt, float* OUT16, int row, int lane) {
    float ss = 0.f;
#pragma unroll
    for (int jj = 0; jj < 4; ++jj) ss += (v[jj][0] * v[jj][0] + v[jj][1] * v[jj][1]) + (v[jj][2] * v[jj][2] + v[jj][3] * v[jj][3]);
    const float rstd = 1.f / sqrtf(wave_sum(ss) * (1.f / DM) + EPS);
    bf16* orow = HN + (size_t)row * DM + 4 * lane;
#pragma unroll
    for (int jj = 0; jj < 4; ++jj) { v[jj] = v[jj] * rstd * gn[jj];
        if (mode == 1) *(unsigned*)((unsigned char*)HN + (size_t)row * DM + 256 * jj + 4 * lane) = pk_fp8x4(v[jj][0] * 8.f, v[jj][1] * 8.f, v[jj][2] * 8.f, v[jj][3] * 8.f);
        else {
#if defined(EMU2) && (EMU2 & 2)
            for (int e_ = 0; e_ < 4; ++e_) v[jj][e_] = q8(v[jj][e_], 16.f);
#endif
            u32x2 o; o.x = cvt_pk_bf16(v[jj][0], v[jj][1]); o.y = cvt_pk_bf16(v[jj][2], v[jj][3]); *(u32x2*)(orow + 256 * jj) = o; } }
    if (mode) {
        float a16[16];
        f32x4 wc[4], wn[4];
#pragma unroll
        for (int jj = 0; jj < 4; ++jj) wc[jj] = *(const LAS f32x4*)(Wt + 256 * jj + 4 * lane);
#pragma unroll
        for (int e = 0; e < 16; ++e) { float a = 0.f;
            if (e + 1 < 16) {
#pragma unroll
                for (int jj = 0; jj < 4; ++jj) wn[jj] = *(const LAS f32x4*)(Wt + (e + 1) * 1028 + 256 * jj + 4 * lane); }
#pragma unroll
            for (int jj = 0; jj < 4; ++jj) { const f32x4 w = wc[jj]; a += (v[jj][0] * w[0] + v[jj][1] * w[1]) + (v[jj][2] * w[2] + v[jj][3] * w[3]); }
            a16[e] = a;
#pragma unroll
            for (int jj = 0; jj < 4; ++jj) wc[jj] = wn[jj];
            __builtin_amdgcn_sched_barrier(0); }
        router_finish(a16, mode, OUT16, row, lane);
    }
}
__device__ __forceinline__ f32x4 ld_row4(const float* p) { return *(const f32x4*)p; }
__device__ __forceinline__ f32x4 ld_row4(const bf16* p) { const u32x2 t = *(const u32x2*)p; return (f32x4){bflo(t.x), bfhi(t.x), bflo(t.y), bfhi(t.y)}; }
__device__ __forceinline__ void norm1_pair(f32x4 (&v0)[4], f32x4 (&v1)[4], const f32x4 (&gn)[4], unsigned char* HN8, const LAS float* Wt, float* AFFo, int row0, int row1, int lane) {
    float s0 = 0.f, s1 = 0.f;
#pragma unroll
    for (int jj = 0; jj < 4; ++jj) { s0 += (v0[jj][0] * v0[jj][0] + v0[jj][1] * v0[jj][1]) + (v0[jj][2] * v0[jj][2] + v0[jj][3] * v0[jj][3]); s1 += (v1[jj][0] * v1[jj][0] + v1[jj][1] * v1[jj][1]) + (v1[jj][2] * v1[jj][2] + v1[jj][3] * v1[jj][3]); }
    const float rs0 = 1.f / sqrtf(wave_sum(s0) * (1.f / DM) + EPS), rs1 = 1.f / sqrtf(wave_sum(s1) * (1.f / DM) + EPS);
#pragma unroll
    for (int jj = 0; jj < 4; ++jj) { v0[jj] = v0[jj] * rs0 * gn[jj]; v1[jj] = v1[jj] * rs1 * gn[jj];
        *(unsigned*)(HN8 + (size_t)row0 * DM + 256 * jj + 4 * lane) = pk_fp8x4(v0[jj][0] * 8.f, v0[jj][1] * 8.f, v0[jj][2] * 8.f, v0[jj][3] * 8.f);
        *(unsigned*)(HN8 + (size_t)row1 * DM + 256 * jj + 4 * lane) = pk_fp8x4(v1[jj][0] * 8.f, v1[jj][1] * 8.f, v1[jj][2] * 8.f, v1[jj][3] * 8.f); }
    float a0[16], a1[16];
    f32x4 wc[4], wn[4];
#pragma unroll
    for (int jj = 0; jj < 4; ++jj) wc[jj] = *(const LAS f32x4*)(Wt + 256 * jj + 4 * lane);
#pragma unroll
    for (int e = 0; e < 16; ++e) { f32x2 acc = (f32x2){0.f, 0.f};
        if (e + 1 < 16) {
#pragma unroll
            for (int jj = 0; jj < 4; ++jj) wn[jj] = *(const LAS f32x4*)(Wt + (e + 1) * 1028 + 256 * jj + 4 * lane); }
#pragma unroll
        for (int jj = 0; jj < 4; ++jj) { const f32x4 w = wc[jj];
            acc += ((f32x2){v0[jj][0], v1[jj][0]} * w[0] + (f32x2){v0[jj][1], v1[jj][1]} * w[1]) + ((f32x2){v0[jj][2], v1[jj][2]} * w[2] + (f32x2){v0[jj][3], v1[jj][3]} * w[3]); }
        a0[e] = acc[0]; a1[e] = acc[1];
#pragma unroll
        for (int jj = 0; jj < 4; ++jj) wc[jj] = wn[jj];
        __builtin_amdgcn_sched_barrier(0); }
    router_finish(a0, 1, AFFo, row0, lane);
    router_finish(a1, 1, AFFo, row1, lane);
}
template <class XT>
__device__ __forceinline__ void norm_phase(LAS unsigned char* lds, const XT* X, const float* gain, bf16* HN, int mode, const float* W16, int ldw, float* OUT16, int vcu, int G, int tid) {
    const int lane = tid & 63, wave = tid >> 6;
    LAS float* Wt = (LAS float*)lds;
    const bool pair = mode == 1 && (T % (2 * G * 8)) == 0;
    f32x4 gn[4];
#pragma unroll
    for (int jj = 0; jj < 4; ++jj) gn[jj] = *(const f32x4*)(gain + 256 * jj + 4 * lane);
    f32x4 vn[4], vm[4];
    {   const int r0 = vcu * 8 + wave; const XT* xr0 = X + (size_t)(r0 < T ? r0 : 0) * DM + 4 * lane;
#pragma unroll
        for (int jj = 0; jj < 4; ++jj) vn[jj] = ld_row4(xr0 + 256 * jj);
        const int r1 = pair ? r0 + G * 8 : r0; const XT* xr1 = X + (size_t)(r1 < T ? r1 : 0) * DM + 4 * lane;
#pragma unroll
        for (int jj = 0; jj < 4; ++jj) vm[jj] = ld_row4(xr1 + 256 * jj); }
    if (mode) norm_fill_w(Wt, W16, ldw, tid);
    __syncthreads();
    if (pair) {
        const int st = G * 8;
        for (int row = vcu * 8 + wave; row < T; row += 2 * st) {
            f32x4 v0[4], v1[4];
            const int rnx = row + 2 * st; const XT* xa = X + (size_t)(rnx < T ? rnx : row) * DM + 4 * lane; const XT* xb = xa + (size_t)st * DM;
#pragma unroll
            for (int jj = 0; jj < 4; ++jj) { v0[jj] = vn[jj]; v1[jj] = vm[jj]; vn[jj] = ld_row4(xa + 256 * jj); vm[jj] = ld_row4(xb + 256 * jj); }
            norm1_pair(v0, v1, gn, (unsigned char*)HN, Wt, OUT16, row, row + st, lane);
        }
    } else
    for (int row = vcu * 8 + wave; row < T; row += G * 8) {
        f32x4 v[4];
        const int rnx = row + G * 8; const XT* xrn = X + (size_t)(rnx < T ? rnx : row) * DM + 4 * lane;
#pragma unroll
        for (int jj = 0; jj < 4; ++jj) { v[jj] = vn[jj]; vn[jj] = ld_row4(xrn + 256 * jj); }
        row_norm_tail(v, gn, HN, mode, Wt, OUT16, row, lane);
    }
    __syncthreads();
}

__device__ __forceinline__ void topk_unit(LAS unsigned char* lds, const float* AFF, int* SEL, int* IDX, float* GATE, int unit, int tid) {
    const int b = unit >> 4, e = unit & 15, lane = tid & 63, wave = tid >> 6;
    LAS unsigned* keys = (LAS unsigned*)lds;
    LAS unsigned* hist = keys + 8192;
    LAS unsigned* misc = hist + 256;
    const unsigned* src = (const unsigned*)(AFF + (size_t)unit * SEQ);
    unsigned mk[16];
#pragma unroll
    for (int i = 0; i < 16; ++i) mk[i] = src[tid * 16 + i];
    unsigned vsel = 0u;
    for (int bit = 30; bit >= 0; --bit) { const unsigned cand = vsel | (1u << bit); float cnt = 0.f;
#pragma unroll
        for (int i = 0; i < 16; ++i) cnt += (mk[i] >= cand) ? 1.f : 0.f;
        cnt = wave_sum(cnt);
        LAS float* part = (LAS float*)(misc + 64 + 8 * (bit & 1));
        if (lane == 0) part[wave] = cnt;
        __syncthreads();
        const float tot = ((part[0] + part[1]) + (part[2] + part[3])) + ((part[4] + part[5]) + (part[6] + part[7]));
        if (tot >= (float)CAP) vsel = cand; }
    unsigned need;
    {   float cnt = 0.f;
#pragma unroll
        for (int i = 0; i < 16; ++i) cnt += (mk[i] > vsel) ? 1.f : 0.f;
        cnt = wave_sum(cnt);
        LAS float* part = (LAS float*)(misc + 96);
        if (lane == 0) part[wave] = cnt;
        __syncthreads();
        const float tot = ((part[0] + part[1]) + (part[2] + part[3])) + ((part[4] + part[5]) + (part[6] + part[7]));
        need = (unsigned)CAP - (unsigned)tot; }
    const unsigned prefix = vsel;
    const unsigned Tk = prefix;
    unsigned cg = 0u, ce = 0u;
#pragma unroll
    for (int i = 0; i < 16; ++i) { cg += (mk[i] > Tk) ? 1u : 0u; ce += (mk[i] == Tk) ? 1u : 0u; }
    unsigned sg = cg, se = ce;
#pragma unroll
    for (int o = 1; o < 64; o <<= 1) { const unsigned tg = shfl_up_u(sg, o, lane), te = shfl_up_u(se, o, lane); if (lane >= o) { sg += tg; se += te; } }
    if (lane == 63) { misc[16 + wave] = sg; misc[32 + wave] = se; }
    __syncthreads();
    unsigned og = sg - cg, oe = se - ce;
    for (int w = 0; w < wave; ++w) { og += misc[16 + w]; oe += misc[32 + w]; }
    const size_t sbase = ((size_t)(e * NB + b)) * CAP;
#pragma unroll
    for (int i = 0; i < 16; ++i) { const int tok = tid * 16 + i; const bool isg = mk[i] > Tk, ise = mk[i] == Tk; const bool sel = isg || (ise && oe < need);
        const unsigned r = og + (oe < need ? oe : need);
        if (sel) { IDX[sbase + r] = tok; GATE[sbase + r] = __uint_as_float(mk[i]); }
        SEL[((size_t)(b * SEQ + tok)) * 16 + e] = sel ? (int)r : -1;
        og += isg ? 1u : 0u; oe += ise ? 1u : 0u; }
    __syncthreads();
}

__device__ __forceinline__ void gather_phase(const bf16* HN, const int* IDX, bf16* XG, int gw, int NGW, int lane) {
    for (int blk = gw; blk < NSLOT / 32; blk += NGW) { const int base = blk * 32, b = (base >> 10) & 3; const int idxv = IDX[base + (lane & 31)];
#pragma unroll 8
        for (int k = 0; k < 32; ++k) { const int tok = __builtin_amdgcn_readlane(idxv, k);
            const u32x4* s = (const u32x4*)(HN + ((size_t)(b * SEQ + tok)) * DM); u32x4* d = (u32x4*)(XG + (size_t)(base + k) * DM);
            const u32x4 a = s[lane], c = s[64 + lane]; d[lane] = a; d[64 + lane] = c; } }
}
__device__ __forceinline__ void combine_phase(LAS unsigned char* lds, bf16* XB, float* XOUT  , const int* SEL, const float* GATE, const unsigned char* YS  , int nmode, const float* gain, bf16* HN, const float* W16, int ldw, float* OUT16, int gw, int NGW, int tid) {
    const int lane = tid & 63;
    LAS float* Wt = (LAS float*)lds;
    f32x4 gn[4];
#pragma unroll
    for (int jj = 0; jj < 4; ++jj) gn[jj] = nmode >= 0 ? *(const f32x4*)(gain + 256 * jj + 4 * lane) : (f32x4){0.f, 0.f, 0.f, 0.f};
    if (nmode > 0) norm_fill_w(Wt, W16, ldw, tid);
    __syncthreads();
    for (int row0 = gw; row0 < T; row0 += 2 * NGW) {
        const int rows[2] = {row0, row0 + NGW < T ? row0 + NGW : row0}; const bool two = row0 + NGW < T;
        int sv[2]; f32x4 v[2][4];
#pragma unroll
        for (int q = 0; q < 2; ++q) { sv[q] = SEL[(size_t)rows[q] * 16 + (lane & 15)];
#pragma unroll
            for (int jj = 0; jj < 4; ++jj) v[q][jj] = ld_row4(XB + (size_t)rows[q] * DM + 4 * lane + 256 * jj); }
        unsigned mask[2]; float gt[2][4]; const unsigned char* yp[2][4];
#pragma unroll
        for (int q = 0; q < 2; ++q) { const int b = rows[q] >> 13; mask[q] = (unsigned)(__ballot(sv[q] >= 0) & 0xffffull);
#pragma unroll
            for (int k = 0; k < 4; ++k) { gt[q][k] = 0.f; yp[q][k] = YS + 4 * lane;
                if (mask[q]) { const int e = __builtin_ctz(mask[q]); mask[q] &= mask[q] - 1u; const int r = __builtin_amdgcn_readlane(sv[q], e); const size_t slot = (size_t)((e * NB + b) * CAP + r); gt[q][k] = GATE[slot] * (1.f / 64.f); yp[q][k] = YS + slot * DM + 4 * lane; } } }
        unsigned y[2][4][4];
#pragma unroll
        for (int q = 0; q < 2; ++q)
#pragma unroll
            for (int k = 0; k < 4; ++k)
#pragma unroll
                for (int jj = 0; jj < 4; ++jj) y[q][k][jj] = *(const unsigned*)(yp[q][k] + 256 * jj);
#pragma unroll
        for (int q = 0; q < 2; ++q) { if (q == 1 && !two) break; const int row = rows[q], b = row >> 13;
#pragma unroll
            for (int k = 0; k < 4; ++k)
#pragma unroll
                for (int jj = 0; jj < 4; ++jj) { const f32x2 lo = __builtin_amdgcn_cvt_pk_f32_fp8((int)y[q][k][jj], false), hi = __builtin_amdgcn_cvt_pk_f32_fp8((int)y[q][k][jj], true);
                    v[q][jj][0] += gt[q][k] * lo[0]; v[q][jj][1] += gt[q][k] * lo[1]; v[q][jj][2] += gt[q][k] * hi[0]; v[q][jj][3] += gt[q][k] * hi[1]; }
            unsigned mk = mask[q];
            while (mk) { const int e = __builtin_ctz(mk); mk &= mk - 1u; const int r = __builtin_amdgcn_readlane(sv[q], e); const size_t slot = (size_t)((e * NB + b) * CAP + r); const float g1 = GATE[slot] * (1.f / 64.f); const unsigned char* yr = YS + slot * DM + 4 * lane;
#pragma unroll
                for (int jj = 0; jj < 4; ++jj) { const int yy = *(const int*)(yr + 256 * jj); const f32x2 lo = __builtin_amdgcn_cvt_pk_f32_fp8(yy, false), hi = __builtin_amdgcn_cvt_pk_f32_fp8(yy, true);
                    v[q][jj][0] += g1 * lo[0]; v[q][jj][1] += g1 * lo[1]; v[q][jj][2] += g1 * hi[0]; v[q][jj][3] += g1 * hi[1]; } }
            bf16* xr = XB + (size_t)row * DM + 4 * lane;
#pragma unroll
            for (int jj = 0; jj < 4; ++jj) { if (XOUT) *(f32x4*)(XOUT + (size_t)row * DM + 4 * lane + 256 * jj) = v[q][jj]; else { u32x2 o; o.x = cvt_pk_bf16(v[q][jj][0], v[q][jj][1]); o.y = cvt_pk_bf16(v[q][jj][2], v[q][jj][3]); *(u32x2*)(xr + 256 * jj) = o; } }
            if (nmode >= 0) row_norm_tail(v[q], gn, HN, nmode, Wt, OUT16, row, lane);
        }
    }
    __syncthreads();
}
__device__ __forceinline__ void moe_convert_phase(LAS unsigned char* lds, const float* WG, const float* WU, const float* WDN, bf16* WGU, bf16* WD, unsigned* ctr, volatile LAS unsigned* slot, int tid, int wave, int lane) {
    LAS float* scr = (LAS float*)lds;
    constexpr int NGU = 16 * 16 * 4, NDN = 16 * 32 * 2;
    auto src_of = [&](int ch, int& ldw) -> const float* {
        if (ch < 2 * NGU) { const int kind = ch / NGU, r = ch % NGU, e = r >> 6, q = r & 63; ldw = 2048; return (kind == 0 ? WG : WU) + (size_t)e * 1024 * 2048 + (size_t)((q >> 2) * 64 + (tid >> 7)) * 2048 + (q & 3) * 512 + 4 * (tid & 127); }
        const int r = ch - 2 * NGU, e = r >> 6, q = r & 63; ldw = 1024; return WDN + (size_t)e * 2048 * 1024 + (size_t)((q >> 1) * 64 + (tid >> 7)) * 1024 + (q & 1) * 512 + 4 * (tid & 127); };
    f32x4 rv[16];
    int ch = wq_next(ctr, slot, tid);
    if (ch < 2 * NGU + NDN) { int ldw; const float* wp = src_of(ch, ldw);
#pragma unroll
        for (int i = 0; i < 16; ++i) rv[i] = *(const f32x4*)(wp + (size_t)(4 * i) * ldw); }
    while (ch < 2 * NGU + NDN) {
        bf16* WT; int Kd, k0, n0, kind;
        if (ch < 2 * NGU) { kind = ch / NGU; const int r = ch % NGU, e = r >> 6, q = r & 63; k0 = (q >> 2) * 64; n0 = (q & 3) * 512; WT = WGU + (size_t)e * 4096 * 512; Kd = 1024; }
        else { kind = 2; const int r = ch - 2 * NGU, e = r >> 6, q = r & 63; k0 = (q >> 1) * 64; n0 = (q & 1) * 512; WT = WD + (size_t)e * 1024 * 1024; Kd = 2048; }
#pragma unroll
        for (int i = 0; i < 16; ++i) { LAS float* d = scr + (4 * i + (tid >> 7)) * 513 + 4 * (tid & 127); d[0] = rv[i][0]; d[1] = rv[i][1]; d[2] = rv[i][2]; d[3] = rv[i][3]; }
        const int chn = wq_next(ctr, slot, tid);
        if (chn < 2 * NGU + NDN) { int ldw; const float* wp = src_of(chn, ldw);
#pragma unroll
            for (int i = 0; i < 16; ++i) rv[i] = *(const f32x4*)(wp + (size_t)(4 * i) * ldw); }
        const int c = tid & 7;
#pragma unroll
        for (int j = 0; j < 8; ++j) { const int n = (tid >> 3) + 64 * j; const LAS float* sp = scr + (8 * c) * 513 + n;
            const int ng = n0 + n, nd = kind == 2 ? ng : ((ng >> 7) * 256 + (kind == 1 ? 128 : 0) + (ng & 127));
            { u32x2 o; o.x = pk_fp8x4(sp[0 * 513] * 64.f, sp[1 * 513] * 64.f, sp[2 * 513] * 64.f, sp[3 * 513] * 64.f); o.y = pk_fp8x4(sp[4 * 513] * 64.f, sp[5 * 513] * 64.f, sp[6 * 513] * 64.f, sp[7 * 513] * 64.f);
                *(u32x2*)((unsigned char*)WT + (size_t)nd * Kd + k0 + 8 * c) = o; } }
        lds_barrier();
        ch = chn;
    }
    __syncthreads();
}
typedef float f32x4_t __attribute__((ext_vector_type(4)));
__device__ __forceinline__ f32x4 mfma16(bf16x8 a, bf16x8 b, f32x4 c) { return __builtin_amdgcn_mfma_f32_16x16x32_bf16(a, b, c, 0, 0, 0); }
__device__ __forceinline__ f32x4 tile_abT(const LAS unsigned char* Ai, const LAS unsigned char* Bi, int ti, int tj, int lane) {
    f32x4 acc = (f32x4){0.f, 0.f, 0.f, 0.f}; bf16x8 a[4], b[4];
#pragma unroll
    for (int ks = 0; ks < 4; ++ks) { a[ks] = *(const LAS bf16x8*)(Ai + (16 * ti + (lane & 15)) * 272 + (32 * ks + 8 * (lane >> 4)) * 2);
        b[ks] = *(const LAS bf16x8*)(Bi + (16 * tj + (lane & 15)) * 272 + (32 * ks + 8 * (lane >> 4)) * 2); }
#pragma unroll
    for (int ks = 0; ks < 4; ++ks) acc = mfma16(a[ks], b[ks], acc);
    return acc;
}
__device__ __forceinline__ size_t fm128(int s, int c, int row, int col) { return ((((size_t)s * 128 + c) * 16 + (row >> 4) * 4 + (col >> 5)) * 512) + ((col >> 3) & 3) * 128 + (row & 15) * 8 + (col & 7); }
__device__ __forceinline__ size_t fmkd(int s, int c, int d, int i) { return ((((size_t)s * 128 + c) * 16 + (d >> 4) * 2 + (i >> 5)) * 512) + ((i >> 3) & 3) * 128 + (d & 15) * 8 + (i & 7); }
__device__ __forceinline__ size_t fmat(int s, int c, int i, int j) { return ((((size_t)s * 128 + c) * 8 + (i >> 4) * 2 + (j >> 5)) * 512) + ((j >> 3) & 3) * 128 + (i & 15) * 8 + (j & 7); }
__device__ __forceinline__ int spos(int dir, int sr) { return dir == 0 ? sr : SEQ - 1 - sr; }

struct HpreIn { u32x4 za, zb; u32x4 qa, qb; };
__device__ __forceinline__ void hpre_load(HpreIn& in, int unit, int tid, const bf16* QS, const bf16* ZF, const bf16* ZB) {
    const int c = unit & 127, s = unit >> 7, h = s & 3, b = (s >> 2) & 3, dir = s >> 4, r = tid >> 3, cg = (tid & 7) * 16;
    const size_t trow = (size_t)b * SEQ + spos(dir, c * 64 + r);
    const bf16* zp = (dir == 0 ? ZF : ZB) + trow * 512 + h * 128 + cg;
    in.za = *(const u32x4*)zp; in.zb = *(const u32x4*)(zp + 8);
    in.qa = *(const u32x4*)(QS + trow * 512 + h * 128 + cg); in.qb = *(const u32x4*)(QS + trow * 512 + h * 128 + cg + 8);
}
__device__ __forceinline__ void hpre_phase(LAS unsigned char* lds, unsigned* ctr, volatile LAS unsigned* slot, int tid, const float* LB  , const bf16* QS, const bf16* ZF, const bf16* ZB,
                                           bf16* QD, bf16* KDT, bf16* AT, float* DEC) {
    const int lane = tid & 63, wave = tid >> 6;
    LAS float* LF = (LAS float*)lds; LAS unsigned char* QT = lds + 33792; LAS unsigned char* KT = lds + 51200; LAS unsigned char* KD = lds + 68608;
    LAS float* SEG = (LAS float*)(lds + 86016); LAS float* ER = (LAS float*)(lds + 88064); LAS float* EB = (LAS float*)(lds + 88576);
    const int r = tid >> 3, cg = (tid & 7) * 16;
    int unit = wq_next(ctr, slot, tid);
    HpreIn nx; if (unit < 4096) hpre_load(nx, unit, tid, QS, ZF, ZB);
    while (unit < 4096) {
        const int c = unit & 127, s = unit >> 7, h = s & 3, b = (s >> 2) & 3, dir = s >> 4;
        const size_t srow = (size_t)dir * T + (size_t)b * SEQ + c * 64 + r;
        const HpreIn in = nx;
        f32x4 lbv[4];
        {   const float* lbp0 = LB + dir * 512 + h * 128 + cg;
#pragma unroll
            for (int e4 = 0; e4 < 4; ++e4) lbv[e4] = *(const f32x4*)(lbp0 + 4 * e4); }
        unsigned tkt = 0u; if (tid == 0) tkt = __hip_atomic_fetch_add(ctr, 1u, __ATOMIC_RELAXED, __HIP_MEMORY_SCOPE_AGENT);
        float q[16], k[16];
        {   const float* lbp = LB + dir * 512 + h * 128 + cg;
            q[0] = bflo(in.qa.x); q[1] = bfhi(in.qa.x); q[2] = bflo(in.qa.y); q[3] = bfhi(in.qa.y); q[4] = bflo(in.qa.z); q[5] = bfhi(in.qa.z); q[6] = bflo(in.qa.w); q[7] = bfhi(in.qa.w);
            q[8] = bflo(in.qb.x); q[9] = bfhi(in.qb.x); q[10] = bflo(in.qb.y); q[11] = bfhi(in.qb.y); q[12] = bflo(in.qb.z); q[13] = bfhi(in.qb.z); q[14] = bflo(in.qb.w); q[15] = bfhi(in.qb.w);
#pragma unroll
            for (int e4 = 0; e4 < 4; ++e4) { const u32x4 zz = e4 < 2 ? in.za : in.zb; const unsigned z01 = (e4 & 1) ? zz.z : zz.x, z23 = (e4 & 1) ? zz.w : zz.y;
                const f32x4 z = (f32x4){bflo(z01), bfhi(z01), bflo(z23), bfhi(z23)}, lb = lbv[e4]; f32x4 lf;
#pragma unroll
                for (int e = 0; e < 4; ++e) { const float sg = fast_rcp(1.f + fast_exp(-z[e])); const float f = lb[e] + (1.f - lb[e]) * sg; lf[e] = fast_log(f); k[4 * e4 + e] = 1.f - f; }
                *(LAS f32x4*)(LF + r * 132 + cg + 4 * e4) = lf; }
        }
        if (tid == 0) *slot = tkt;
        lds_barrier();
        const int nunit = (int)*slot;
        if (nunit < 4096) hpre_load(nx, nunit, tid, QS, ZF, ZB);
        {   const int seg = tid >> 7, col = tid & 127; float run = 0.f, lv[16];
#pragma unroll
            for (int i = 0; i < 16; ++i) lv[i] = LF[(16 * seg + i) * 132 + col];
#pragma unroll
            for (int i = 0; i < 16; ++i) { run += lv[i]; lv[i] = run; }
            SEG[seg * 128 + col] = run;
            lds_barrier();
            float off = 0.f; for (int s2 = 0; s2 < seg; ++s2) off += SEG[s2 * 128 + col];
#pragma unroll
            for (int i = 0; i < 16; ++i) LF[(16 * seg + i) * 132 + col] = lv[i] + off;
            if (seg == 0) { const float b31 = SEG[col] + SEG[128 + col], b63 = b31 + SEG[256 + col] + SEG[384 + col];
                ER[col] = fast_exp(b31); EB[col] = fast_exp(b63 - b31); DEC[((size_t)s * 128 + c) * 128 + col] = fast_exp(b63); }
        }
        lds_barrier();
        {   float qt[16], kt[16], qd[16], kd[16];
#pragma unroll
            for (int e = 0; e < 16; ++e) { const float bb = LF[r * 132 + cg + e], rr = LF[31 * 132 + cg + e];
                qt[e] = q[e] * fast_exp(fminf(bb - rr, 60.f)); kt[e] = k[e] * fast_exp(fminf(rr - bb, 60.f)); qd[e] = qt[e] * ER[cg + e]; kd[e] = kt[e] * EB[cg + e]; }
            u32x4 o0, o1;
            o0.x = cvt_pk_bf16(qt[0], qt[1]); o0.y = cvt_pk_bf16(qt[2], qt[3]); o0.z = cvt_pk_bf16(qt[4], qt[5]); o0.w = cvt_pk_bf16(qt[6], qt[7]);
            o1.x = cvt_pk_bf16(qt[8], qt[9]); o1.y = cvt_pk_bf16(qt[10], qt[11]); o1.z = cvt_pk_bf16(qt[12], qt[13]); o1.w = cvt_pk_bf16(qt[14], qt[15]);
            *(LAS u32x4*)(QT + r * 272 + cg * 2) = o0; *(LAS u32x4*)(QT + r * 272 + cg * 2 + 16) = o1;
            o0.x = cvt_pk_bf16(kt[0], kt[1]); o0.y = cvt_pk_bf16(kt[2], kt[3]); o0.z = cvt_pk_bf16(kt[4], kt[5]); o0.w = cvt_pk_bf16(kt[6], kt[7]);
            o1.x = cvt_pk_bf16(kt[8], kt[9]); o1.y = cvt_pk_bf16(kt[10], kt[11]); o1.z = cvt_pk_bf16(kt[12], kt[13]); o1.w = cvt_pk_bf16(kt[14], kt[15]);
            *(LAS u32x4*)(KT + r * 272 + cg * 2) = o0; *(LAS u32x4*)(KT + r * 272 + cg * 2 + 16) = o1;
            o0.x = cvt_pk_bf16(kd[0], kd[1]); o0.y = cvt_pk_bf16(kd[2], kd[3]); o0.z = cvt_pk_bf16(kd[4], kd[5]); o0.w = cvt_pk_bf16(kd[6], kd[7]);
            o1.x = cvt_pk_bf16(kd[8], kd[9]); o1.y = cvt_pk_bf16(kd[10], kd[11]); o1.z = cvt_pk_bf16(kd[12], kd[13]); o1.w = cvt_pk_bf16(kd[14], kd[15]);
            *(LAS u32x4*)(KD + r * 272 + cg * 2) = o0; *(LAS u32x4*)(KD + r * 272 + cg * 2 + 16) = o1;
            o0.x = cvt_pk_bf16(qd[0], qd[1]); o0.y = cvt_pk_bf16(qd[2], qd[3]); o0.z = cvt_pk_bf16(qd[4], qd[5]); o0.w = cvt_pk_bf16(qd[6], qd[7]);
            o1.x = cvt_pk_bf16(qd[8], qd[9]); o1.y = cvt_pk_bf16(qd[10], qd[11]); o1.z = cvt_pk_bf16(qd[12], qd[13]); o1.w = cvt_pk_bf16(qd[14], qd[15]);
            *(u32x4*)(QD + fm128(s, c, r, cg)) = o0; *(u32x4*)(QD + fm128(s, c, r, cg + 8)) = o1;
        }
        lds_barrier();
        {
            const int l15_ = lane & 15, g_ = lane >> 4, q_ = l15_ >> 2, p_ = l15_ & 3, d = 16 * wave + l15_, i0 = 16 * g_;
            const LAS unsigned char* tp = KD + (i0 + q_) * 272 + (16 * wave + 4 * p_) * 2;
            const u32x2 t0 = lds_tr16(tp), t1 = lds_tr16(tp + 4 * 272), t2 = lds_tr16(tp + 8 * 272), t3 = lds_tr16(tp + 12 * 272);
            const u32x4 o0 = (u32x4){t0.x, t0.y, t1.x, t1.y}, o1 = (u32x4){t2.x, t2.y, t3.x, t3.y};
            *(u32x4*)(KDT + fmkd(s, c, d, i0)) = o0; *(u32x4*)(KDT + fmkd(s, c, d, i0 + 8)) = o1; }
#pragma unroll
        for (int tt = 0; tt < 2; ++tt) { const int idx = 2 * wave + tt, ti = idx >> 2, tj = idx & 3;
            f32x4 p = (f32x4){0.f, 0.f, 0.f, 0.f};
            if (tj <= ti) p = tile_abT(QT, KT, ti, tj, lane);
            const int j = 16 * tj + (lane & 15);
#pragma unroll
            for (int e = 0; e < 4; ++e) { const int i = 16 * ti + 4 * (lane >> 4) + e; AT[fmat(s, c, i, j)] = f2bf(j <= i ? p[e] : 0.f); } }
        lds_barrier();
        unit = nunit;
    }
}

struct GpreIn { u32x4 k0, k1, q0, q1, v0, v1; float g, bt; };
__device__ __forceinline__ void gpre_load(GpreIn& in, int unit, int tid, const bf16* GQ, const bf16* GK, const bf16* GV, const float* GG, const float* GBT) {
    const int c = unit & 127, s = unit >> 7, h = s & 3, b = (s >> 2) & 3, dir = s >> 4, r = tid >> 3, cg = (tid & 7) * 16;
    const size_t go = ((size_t)b * SEQ + spos(dir, c * 64 + r)) * 512 + h * 128 + cg;
    in.k0 = *(const u32x4*)(GK + go); in.k1 = *(const u32x4*)(GK + go + 8); in.q0 = *(const u32x4*)(GQ + go); in.q1 = *(const u32x4*)(GQ + go + 8); in.v0 = *(const u32x4*)(GV + go); in.v1 = *(const u32x4*)(GV + go + 8);
    const size_t tr2 = (size_t)b * SEQ + spos(dir, c * 64 + (tid & 63)); in.g = GG[tr2 * 8 + dir * 4 + h]; in.bt = GBT[tr2 * 8 + dir * 4 + h];
}
template <int VAR>
__device__ __forceinline__ void gpre_phase(LAS unsigned char* lds, int bx, int G, int tid, const bf16* GQ, const bf16* GK, const bf16* GV, const float* GG, const float* GBT,
                                           bf16* QD, bf16* KDT, bf16* VAL, bf16* KC, bf16* AT, float* DEC) {
    const int lane = tid & 63, wave = __builtin_amdgcn_readfirstlane(tid >> 6), l15 = lane & 15, l4 = lane >> 4;
    LAS float* FK = (LAS float*)(lds + 141824);
    LAS unsigned char* KL = lds; LAS unsigned char* QL = lds + 17408; LAS unsigned char* VL = lds + 34816; LAS float* AM = (LAS float*)(lds + 52224);
    LAS float* GAM = (LAS float*)(lds + 69632); LAS float* BETA = (LAS float*)(lds + 69888);
    LAS unsigned char* AMB = lds + 70144; LAS unsigned char* XTB = lds + 79360; LAS unsigned char* DB = lds + 116224; LAS unsigned char* RB = lds + 121344;
    GpreIn nx; if (bx < 4096) gpre_load(nx, bx, tid, GQ, GK, GV, GG, GBT);
    for (int unit = bx; unit < 4096; unit += G) {
        const int c = unit & 127, s = unit >> 7, h = s & 3, b = (s >> 2) & 3, dir = s >> 4;
        {   const int r = tid >> 3, cg = (tid & 7) * 16;
            *(LAS u32x4*)(KL + r * 272 + cg * 2) = nx.k0; *(LAS u32x4*)(KL + r * 272 + cg * 2 + 16) = nx.k1;
            *(LAS u32x4*)(QL + r * 272 + cg * 2) = nx.q0; *(LAS u32x4*)(QL + r * 272 + cg * 2 + 16) = nx.q1;
            *(LAS u32x4*)(VL + r * 272 + cg * 2) = nx.v0; *(LAS u32x4*)(VL + r * 272 + cg * 2 + 16) = nx.v1;
            if (tid < 64) { float gsum = nx.g; BETA[tid] = nx.bt;
#pragma unroll
                for (int o = 1; o < 64; o <<= 1) { const float t = shfl_up_f(gsum, o, lane); if (lane >= o) gsum += t; }
                GAM[tid] = gsum; }
            for (int i = tid; i < (36864 + 5120 + 20480) / 16; i += 512) ((LAS u32x4*)XTB)[i] = (u32x4){0u, 0u, 0u, 0u};
        }
        if (unit + G < 4096) gpre_load(nx, unit + G, tid, GQ, GK, GV, GG, GBT);
        lds_barrier();
        const float gl = GAM[63];
#pragma unroll
        for (int tt = 0; tt < 2; ++tt) { if (VAR & 2) break; const int idx = 2 * wave + tt, ti = idx >> 2, tj = idx & 3;
            f32x4 kk = (f32x4){0.f, 0.f, 0.f, 0.f}, qk = kk;
            if (tj <= ti) { kk = tile_abT(KL, KL, ti, tj, lane); qk = tile_abT(QL, KL, ti, tj, lane); }
            const int j = 16 * tj + l15; const float gj = GAM[j];
            const f32x4 gi4 = *(const LAS f32x4*)(GAM + 16 * ti + 4 * l4), bi4 = *(const LAS f32x4*)(BETA + 16 * ti + 4 * l4);
#pragma unroll
            for (int e = 0; e < 4; ++e) { const int i = 16 * ti + 4 * l4 + e; const float dcy = fast_exp(fminf(gi4[e] - gj, 0.f));
                const float av = (j < i) ? bi4[e] * kk[e] * dcy : 0.f;
                AM[i * 68 + j] = av; *(LAS unsigned short*)(AMB + i * 144 + j * 2) = f2bf(av);
                if (!(VAR & 4)) AT[fmat(s, c, i, j)] = f2bf(j <= i ? qk[e] * dcy : 0.f); } }
        lds_barrier();
        if (tid < 64) { const int bb = tid >> 4, cc = tid & 15; float x[16];
            const LAS float* Ab = AM + (16 * bb) * 68 + 16 * bb;
            f32x4 P[16][4];
#pragma unroll
            for (int ii = 1; ii <= 12; ++ii)
#pragma unroll
                for (int q = 0; q < (ii + 3) / 4; ++q) P[ii][q] = *(const LAS f32x4*)(Ab + ii * 68 + 4 * q);
            __builtin_amdgcn_sched_barrier(0);
#pragma unroll
            for (int ii = 0; ii <= 8; ++ii) { float acc = (ii == cc) ? 1.f : 0.f;
#pragma unroll
                for (int jj = 0; jj < ii; ++jj) acc -= P[ii][jj >> 2][jj & 3] * x[jj];
                x[ii] = acc; }
            __builtin_amdgcn_sched_barrier(0);
#pragma unroll
            for (int ii = 13; ii <= 15; ++ii)
#pragma unroll
                for (int q = 0; q < 4; ++q) P[ii][q] = *(const LAS f32x4*)(Ab + ii * 68 + 4 * q);
            __builtin_amdgcn_sched_barrier(0);
#pragma unroll
            for (int ii = 9; ii < 16; ++ii) { float acc = (ii == cc) ? 1.f : 0.f;
#pragma unroll
                for (int jj = 0; jj < ii; ++jj) acc -= P[ii][jj >> 2][jj & 3] * x[jj];
                x[ii] = acc; }
#pragma unroll
            for (int ii = 0; ii < 16; ++ii) *(LAS unsigned short*)(DB + (16 * bb + ii) * 80 + cc * 2) = f2bf(x[ii]);
        } else if (tid < 128) { const int i = tid - 64; FK[i] = BETA[i] * fast_exp(GAM[i]);
        } else if (tid >= 256) {
            const int t2 = tid - 256;
            {   const int r = t2 >> 2, cg = (t2 & 3) * 32; const float eg = fast_exp(GAM[r]); const size_t srow = (size_t)dir * T + (size_t)b * SEQ + c * 64 + r;
#pragma unroll
                for (int e8 = 0; e8 < 4; ++e8) { const u32x4 qv = *(const LAS u32x4*)(QL + r * 272 + (cg + 8 * e8) * 2); u32x4 o;
                    o.x = cvt_pk_bf16(bflo(qv.x) * eg, bfhi(qv.x) * eg); o.y = cvt_pk_bf16(bflo(qv.y) * eg, bfhi(qv.y) * eg); o.z = cvt_pk_bf16(bflo(qv.z) * eg, bfhi(qv.z) * eg); o.w = cvt_pk_bf16(bflo(qv.w) * eg, bfhi(qv.w) * eg);
                    *(u32x4*)(QD + fm128(s, c, r, cg + 8 * e8)) = o; } }
#pragma unroll
            for (int rep = 0; rep < 2; ++rep) {
                const int l15_ = lane & 15, g_ = lane >> 4, q_ = l15_ >> 2, p_ = l15_ & 3, dblk = 2 * (wave - 4) + rep, d = 16 * dblk + l15_, i0 = 16 * g_; float v[16];
                const LAS unsigned char* tp = KL + (i0 + q_) * 272 + (16 * dblk + 4 * p_) * 2;
                u32x2 tr[4]; f32x4 gm[4];
#pragma unroll
                for (int k4 = 0; k4 < 4; ++k4) { tr[k4] = lds_tr16(tp + 4 * k4 * 272); gm[k4] = *(const LAS f32x4*)(GAM + i0 + 4 * k4); }
#pragma unroll
                for (int k4 = 0; k4 < 4; ++k4) { v[4 * k4] = bflo(tr[k4].x) * fast_exp(gl - gm[k4][0]); v[4 * k4 + 1] = bfhi(tr[k4].x) * fast_exp(gl - gm[k4][1]); v[4 * k4 + 2] = bflo(tr[k4].y) * fast_exp(gl - gm[k4][2]); v[4 * k4 + 3] = bfhi(tr[k4].y) * fast_exp(gl - gm[k4][3]); }
                u32x4 o0, o1;
                o0.x = cvt_pk_bf16(v[0], v[1]); o0.y = cvt_pk_bf16(v[2], v[3]); o0.z = cvt_pk_bf16(v[4], v[5]); o0.w = cvt_pk_bf16(v[6], v[7]);
                o1.x = cvt_pk_bf16(v[8], v[9]); o1.y = cvt_pk_bf16(v[10], v[11]); o1.z = cvt_pk_bf16(v[12], v[13]); o1.w = cvt_pk_bf16(v[14], v[15]);
                *(u32x4*)(KDT + fmkd(s, c, d, i0)) = o0; *(u32x4*)(KDT + fmkd(s, c, d, i0 + 8)) = o1; }
            if (t2 < 128) DEC[((size_t)s * 128 + c) * 128 + t2] = fast_exp(gl);
        }
        lds_barrier();
        for (int bb = 0; bb < 4; ++bb) {
            const int nks = bb == 3 ? 2 : 1;
#pragma unroll
            for (int tt = 0; tt < 2; ++tt) { const int ct = 2 * wave + tt, col = 16 * ct + l15; f32x4 acc = (f32x4){0.f, 0.f, 0.f, 0.f};
                if (bb > 0) for (int ks = 0; ks < nks; ++ks) { const bf16x8 af = *(const LAS bf16x8*)(AMB + (16 * bb + l15) * 144 + (32 * ks + 8 * l4) * 2);
                    const bf16x8 bf = *(const LAS bf16x8*)(XTB + col * 144 + (32 * ks + 8 * l4) * 2); acc = mfma16(af, bf, acc); }
                const bool isk = wave >= 4;
                const LAS unsigned char* src = isk ? KL : VL; float r[4];
                const f32x4 f4 = *(const LAS f32x4*)((isk ? FK : BETA) + 16 * bb + 4 * l4);
                unsigned short sv[4];
#pragma unroll
                for (int e = 0; e < 4; ++e) sv[e] = *(const LAS unsigned short*)(src + (16 * bb + 4 * l4 + e) * 272 + (col & 127) * 2);
#pragma unroll
                for (int e = 0; e < 4; ++e) r[e] = bf2f(sv[e]) * f4[e] - acc[e];
                u32x2 w; w.x = cvt_pk_bf16(r[0], r[1]); w.y = cvt_pk_bf16(r[2], r[3]);
                *(LAS u32x2*)(RB + col * 80 + (4 * l4) * 2) = w; }
            lds_barrier();
#pragma unroll
            for (int tt = 0; tt < 2; ++tt) { const int ct = 2 * wave + tt, col = 16 * ct + l15;
                const bf16x8 af = *(const LAS bf16x8*)(DB + (16 * bb + l15) * 80 + (8 * l4) * 2), bf = *(const LAS bf16x8*)(RB + col * 80 + (8 * l4) * 2);
                const f32x4 x = mfma16(af, bf, (f32x4){0.f, 0.f, 0.f, 0.f});
                u32x2 w; w.x = cvt_pk_bf16(x[0], x[1]); w.y = cvt_pk_bf16(x[2], x[3]);
                *(LAS u32x2*)(XTB + col * 144 + (16 * bb + 4 * l4) * 2) = w;
                if (col >= 128) {
#pragma unroll
                    for (int e = 0; e < 4; ++e) KC[fm128(s, c, 16 * bb + 4 * l4 + e, col & 127)] = f2bf(x[e]); }
                else { bf16* dst = VAL + ((size_t)dir * T + (size_t)b * SEQ + c * 64 + 16 * bb + 4 * l4) * 512 + h * 128 + col;
#pragma unroll
                    for (int e = 0; e < 4; ++e) dst[(size_t)e * 512] = f2bf(x[e]); } }
            lds_barrier();
        }
    }
}

struct ScanOpsA { bf16x8 qd[4], kc[4], at[2]; u32x2 val[4]; };
struct ScanOpsB { bf16x8 kd[2][2]; f32x4 dec[2]; };
#define SCAN_LD4(dst, voff, base, imm) asm volatile("global_load_dwordx4 %0, %1, %2 offset:" #imm : "=&v"(dst) : "v"(voff), "s"(base) : "memory")
#define SCAN_LD2(dst, voff, base, imm) asm volatile("global_load_dwordx2 %0, %1, %2 offset:" #imm : "=&v"(dst) : "v"(voff), "s"(base) : "memory")
template <bool GDN>
__device__ __forceinline__ void scan_load_a(ScanOpsA& o, int c, size_t rb, int s, int h, int sl, int ti, int l15, int l4, const bf16* QD, const bf16* VAL, const bf16* KC, const bf16* AT) {
    const unsigned vfrag = (unsigned)(16 * l4 + l15) * 16u;
    const size_t cb = ((size_t)s * 128 + c) * 8192 + (size_t)(ti * 4) * 512;
    const bf16* bq = QD + cb; const bf16* bk = KC + cb; const bf16* ba = AT + ((size_t)s * 128 + c) * 4096 + (size_t)(ti * 2) * 512;
    SCAN_LD4(o.qd[0], vfrag, bq, 0); SCAN_LD4(o.qd[1], vfrag, bq, 1024); SCAN_LD4(o.qd[2], vfrag, bq, 2048); SCAN_LD4(o.qd[3], vfrag, bq, 3072);
    if (GDN) { SCAN_LD4(o.kc[0], vfrag, bk, 0); SCAN_LD4(o.kc[1], vfrag, bk, 1024); SCAN_LD4(o.kc[2], vfrag, bk, 2048); SCAN_LD4(o.kc[3], vfrag, bk, 3072); }
    SCAN_LD4(o.at[0], vfrag, ba, 0); SCAN_LD4(o.at[1], vfrag, ba, 1024);
    const int sr0 = c * 64 + 16 * ti;
    if (GDN || !(s >> 4)) { const size_t r0 = GDN ? rb + sr0 : (size_t)((s >> 2) & 3) * SEQ + sr0;
        const bf16* bv = VAL + r0 * 512 + h * 128 + 64 * sl; const unsigned vv = (unsigned)(4 * l4) * 1024u + (unsigned)l15 * 8u;
        SCAN_LD2(o.val[0], vv, bv, 0); SCAN_LD2(o.val[1], vv, bv, 1024); SCAN_LD2(o.val[2], vv, bv, 2048); SCAN_LD2(o.val[3], vv, bv, 3072); }
    else { const size_t r0 = (size_t)((s >> 2) & 3) * SEQ + (SEQ - 1 - (sr0 + 15));
        const bf16* bv = VAL + r0 * 512 + h * 128 + 64 * sl; const unsigned vv = (unsigned)(15 - 4 * l4) * 1024u + (unsigned)l15 * 8u;
        SCAN_LD2(o.val[0], vv, bv, 0); SCAN_LD2(o.val[1], vv, bv, -1024); SCAN_LD2(o.val[2], vv, bv, -2048); SCAN_LD2(o.val[3], vv, bv, -3072); }
}
__device__ __forceinline__ void scan_load_b(ScanOpsB& o, int c, int s, int w4, int l15, int l4, const bf16* KDT, const float* DEC) {
    const unsigned vfrag = (unsigned)(16 * l4 + l15) * 16u, vdec = (unsigned)l4 * 16u;
    const bf16* bk = KDT + ((size_t)s * 128 + c) * 8192 + (size_t)(2 * w4 * 2) * 512; const float* bd = DEC + ((size_t)s * 128 + c) * 128 + 16 * (2 * w4);
    SCAN_LD4(o.kd[0][0], vfrag, bk, 0); SCAN_LD4(o.kd[0][1], vfrag, bk, 1024); SCAN_LD4(o.kd[1][0], vfrag, bk, 2048); SCAN_LD4(o.kd[1][1], vfrag, bk, 3072);
    SCAN_LD4(o.dec[0], vdec, bd, 0); SCAN_LD4(o.dec[1], vdec, bd, 64);
}
#define SCAN_WAIT(n) asm volatile("s_waitcnt vmcnt(" #n ")" ::: "memory")
template <bool GDN>
__device__ __forceinline__ void scan_touch_a(ScanOpsA& o) {
#pragma unroll
    for (int i = 0; i < 4; ++i) { asm volatile("" : "+v"(o.qd[i])); if (GDN) asm volatile("" : "+v"(o.kc[i])); asm volatile("" : "+v"(o.val[i])); }
    asm volatile("" : "+v"(o.at[0])); asm volatile("" : "+v"(o.at[1]));
}
__device__ __forceinline__ void scan_touch_b(ScanOpsB& o) {
#pragma unroll
    for (int i = 0; i < 2; ++i) { asm volatile("" : "+v"(o.kd[i][0])); asm volatile("" : "+v"(o.kd[i][1])); asm volatile("" : "+v"(o.dec[i])); }
}
template <bool GDN>
__device__ __forceinline__ void scan_unit(LAS unsigned char* lds, int unit, int tid, const bf16* QD, const bf16* KDT, const bf16* VAL, const bf16* KC, const bf16* AT, const float* DEC, bf16* OS) {
    const int sl = unit & 1, s = unit >> 1, h = s & 3, b = (s >> 2) & 3, dir = s >> 4, lane = tid & 63, wave = __builtin_amdgcn_readfirstlane(tid >> 6);
    const int l15 = lane & 15, l4 = lane >> 4;
    LAS unsigned char* ST = lds; LAS unsigned char* VN = lds + 34816;
    for (int i = tid; i < (34816 + 9216) / 4; i += 512) ((LAS unsigned*)lds)[i] = 0u;
    lds_barrier();
    const size_t rb = (size_t)dir * T + (size_t)b * SEQ;
    int cur = 0;
    constexpr int NST = GDN ? 3 : 4, PD = NST - 1;
    if (wave < 4) {
        const int ti = wave;
        ScanOpsA st[NST];
#pragma unroll
        for (int i = 0; i < PD; ++i) scan_load_a<GDN>(st[i], i, rb, s, h, sl, ti, l15, l4, QD, VAL, KC, AT);
#pragma nounroll
        for (int c0 = 0; c0 < NCH; c0 += NST) {
#pragma unroll
            for (int u = 0; u < NST; ++u) { const int c = c0 + u; if (c >= NCH) break;
                if (c + PD < NCH) { scan_load_a<GDN>(st[(u + PD) % NST], c + PD, rb, s, h, sl, ti, l15, l4, QD, VAL, KC, AT);
                    if (c < PD) { if (GDN) SCAN_WAIT(28); else SCAN_WAIT(30); }
                    else { if (GDN) SCAN_WAIT(36); else SCAN_WAIT(42); } }
                else SCAN_WAIT(0);
                scan_touch_a<GDN>(st[u]);
                const ScanOpsA& op = st[u];
                const LAS unsigned char* STc = ST + cur * 17408;
                f32x4 o[4]; bf16x8 sB[4], sBn[4];
#pragma unroll
                for (int ks = 0; ks < 4; ++ks) sB[ks] = *(const LAS bf16x8*)(STc + l15 * 272 + (32 * ks + 8 * l4) * 2);
#pragma unroll
                for (int ct = 0; ct < 4; ++ct) {
                    if (ct + 1 < 4) {
#pragma unroll
                        for (int ks = 0; ks < 4; ++ks) sBn[ks] = *(const LAS bf16x8*)(STc + (16 * (ct + 1) + l15) * 272 + (32 * ks + 8 * l4) * 2); }
                    f32x4 vn;
#pragma unroll
                    for (int e = 0; e < 4; ++e) { const unsigned w2 = ct < 2 ? op.val[e].x : op.val[e].y; vn[e] = (ct & 1) ? bfhi(w2) : bflo(w2); }
                    if (GDN) { f32x4 ks_ = (f32x4){0.f, 0.f, 0.f, 0.f};
#pragma unroll
                        for (int ks = 0; ks < 4; ++ks) ks_ = mfma16(op.kc[ks], sB[ks], ks_);
                        vn = vn - ks_; }
                    {   u32x2 w; w.x = cvt_pk_bf16(vn[0], vn[1]); w.y = cvt_pk_bf16(vn[2], vn[3]);
                        *(LAS u32x2*)(VN + (16 * ct + l15) * 144 + (16 * ti + 4 * l4) * 2) = w; }
                    f32x4 oc = (f32x4){0.f, 0.f, 0.f, 0.f};
#pragma unroll
                    for (int ks = 0; ks < 4; ++ks) oc = mfma16(op.qd[ks], sB[ks], oc);
                    o[ct] = oc;
#pragma unroll
                    for (int ks = 0; ks < 4; ++ks) sB[ks] = sBn[ks]; }
                lds_barrier();
                {   bf16x8 vbA[4][2];
#pragma unroll
                    for (int ct = 0; ct < 4; ++ct)
#pragma unroll
                        for (int ks = 0; ks < 2; ++ks) vbA[ct][ks] = *(const LAS bf16x8*)(VN + (16 * ct + l15) * 144 + (32 * ks + 8 * l4) * 2);
#pragma unroll
                    for (int ct = 0; ct < 4; ++ct) { f32x4 oc = o[ct];
#pragma unroll
                        for (int ks = 0; ks < 2; ++ks) oc = mfma16(op.at[ks], vbA[ct][ks], oc);
                        o[ct] = oc; } }
#pragma unroll
                for (int e = 0; e < 4; ++e) { u32x2 w; w.x = cvt_pk_bf16(o[0][e], o[1][e]); w.y = cvt_pk_bf16(o[2][e], o[3][e]); *(u32x2*)(OS + (rb + c * 64 + 16 * ti + 4 * l4 + e) * 512 + h * 128 + 64 * sl + 4 * l15) = w; }
                lds_barrier();
                cur ^= 1;
            }
        }
    } else {
        const int w4 = wave - 4;
        f32x4 Sacc[2][4];
#pragma unroll
        for (int dd = 0; dd < 2; ++dd)
#pragma unroll
            for (int t2 = 0; t2 < 4; ++t2) Sacc[dd][t2] = (f32x4){0.f, 0.f, 0.f, 0.f};
        ScanOpsB st[NST];
#pragma unroll
        for (int i = 0; i < PD; ++i) scan_load_b(st[i], i, s, w4, l15, l4, KDT, DEC);
#pragma nounroll
        for (int c0 = 0; c0 < NCH; c0 += NST) {
#pragma unroll
            for (int u = 0; u < NST; ++u) { const int c = c0 + u; if (c >= NCH) break;
                if (c + PD < NCH) { scan_load_b(st[(u + PD) % NST], c + PD, s, w4, l15, l4, KDT, DEC); if (GDN) SCAN_WAIT(12); else SCAN_WAIT(18); }
                else SCAN_WAIT(0);
                scan_touch_b(st[u]);
                const ScanOpsB& op = st[u];
                lds_barrier();
                LAS unsigned char* STn = ST + (cur ^ 1) * 17408;
                bf16x8 vbB[4][2];
#pragma unroll
                for (int t2 = 0; t2 < 4; ++t2)
#pragma unroll
                    for (int ks = 0; ks < 2; ++ks) vbB[t2][ks] = *(const LAS bf16x8*)(VN + (16 * t2 + l15) * 144 + (32 * ks + 8 * l4) * 2);
#pragma unroll
                for (int t2 = 0; t2 < 4; ++t2) {
#pragma unroll
                    for (int dd = 0; dd < 2; ++dd) { f32x4 a = Sacc[dd][t2] * op.dec[dd];
#pragma unroll
                        for (int ks = 0; ks < 2; ++ks) a = mfma16(op.kd[dd][ks], vbB[t2][ks], a);
                        Sacc[dd][t2] = a;
                        u32x2 w; w.x = cvt_pk_bf16(a[0], a[1]); w.y = cvt_pk_bf16(a[2], a[3]);
                        *(LAS u32x2*)(STn + (16 * t2 + l15) * 272 + (16 * (2 * w4 + dd) + 4 * l4) * 2) = w; } }
                lds_barrier();
                cur ^= 1;
            }
        }
    }
}
__device__ __forceinline__ void oprep_unit(LAS unsigned char* lds, int unit, int tid, const bf16* PO, const float* AB, const float* convw  , const float* alog  , const float* dtb  ,
                                           const float* qg, const float* kg, bf16* AQ, bf16* AK, bf16* AVT, bf16* GQ, bf16* GK, bf16* GV, float* GG, float* GBT) {
    const int h = unit & 3, tb = (unit >> 2) & 127, b = unit >> 9, lane = tid & 63, wave = tid >> 6;
    const u32x4 zero4 = (u32x4){0u, 0u, 0u, 0u};
    {   u32x4 va[7], vb[6];
#pragma unroll
        for (int i = 0; i < 7; ++i) { const int p = tid + 512 * i, pc = p & 15, rr = p >> 4, t = rr >= 136 ? 2 : (rr >= 68 ? 1 : 0), row = rr - t * 68; const int pos = tb * 64 - 2 + row;
            const int posc = pos < 0 ? 0 : (pos >= SEQ ? SEQ - 1 : pos);
            va[i] = zero4; if (i < 6 || tid < 192) va[i] = *(const u32x4*)(PO + ((size_t)b * SEQ + posc) * ODD_N + 1536 + t * 512 + h * 128 + pc * 8);
            if (pos < 0 || pos >= SEQ) va[i] = zero4; }
#pragma unroll
        for (int i = 0; i < 6; ++i) { const int p2 = tid + 512 * i, t = p2 >> 10, row = (p2 & 1023) >> 4, pc = p2 & 15;
            vb[i] = *(const u32x4*)(PO + ((size_t)b * SEQ + tb * 64 + row) * ODD_N + t * 512 + h * 128 + pc * 8); }
#pragma unroll
        for (int i = 0; i < 7; ++i) { const int p = tid + 512 * i, pc = p & 15, rr = p >> 4, t = rr >= 136 ? 2 : (rr >= 68 ? 1 : 0), row = rr - t * 68;
            if (i < 6 || tid < 192) *(LAS u32x4*)(lds + t * 18496 + row * 272 + pc * 16) = va[i]; }
#pragma unroll
        for (int i = 0; i < 6; ++i) { const int p2 = tid + 512 * i, t = p2 >> 10, row = (p2 & 1023) >> 4, pc = p2 & 15;
            *(LAS u32x4*)(lds + 55488 + t * 17408 + row * 272 + pc * 16) = vb[i]; }
    }
    float w[3][5][2];
#pragma unroll
    for (int t3 = 0; t3 < 3; ++t3)
#pragma unroll
        for (int tap = 0; tap < 5; ++tap) { const f32x2 ww = *(const f32x2*)(convw + tap * 1536 + t3 * 512 + h * 128 + 2 * lane); w[t3][tap][0] = ww[0]; w[t3][tap][1] = ww[1]; }
    const f32x2 qg2 = *(const f32x2*)(qg + 2 * (lane & 31)), kg2 = *(const f32x2*)(kg + 2 * (lane & 31));
    const float qgs = 0.125f * LOG2E;
    float gav = 0.f, gbv = 0.f;
    if (tid < 128) { const size_t grow = (size_t)b * SEQ + tb * 64 + (tid >> 1); const int dir = tid & 1; gav = AB[grow * 16 + dir * 4 + h] + dtb[dir * 4 + h]; gbv = AB[grow * 16 + 8 + dir * 4 + h]; }
    lds_barrier();
    {
        float xw[3][5][2];
        unsigned xrow[3][12], qrow[8], krow[8];
#pragma unroll
        for (int t3 = 0; t3 < 3; ++t3)
#pragma unroll
            for (int rr = 0; rr < 12; ++rr) xrow[t3][rr] = *(const LAS unsigned*)(lds + t3 * 18496 + (wave * 8 + rr) * 272 + 4 * lane);
#pragma unroll
        for (int tt = 0; tt < 8; ++tt) { qrow[tt] = *(const LAS unsigned*)(lds + 55488 + (wave * 8 + tt) * 272 + 4 * lane); krow[tt] = *(const LAS unsigned*)(lds + 72896 + (wave * 8 + tt) * 272 + 4 * lane); }
#pragma unroll
        for (int t3 = 0; t3 < 3; ++t3)
#pragma unroll
            for (int tap = 1; tap < 5; ++tap) { const unsigned xv = xrow[t3][tap - 1]; xw[t3][tap][0] = bflo(xv); xw[t3][tap][1] = bfhi(xv); }
#pragma unroll
        for (int tt = 0; tt < 8; ++tt) { const int tok = wave * 8 + tt, pos = tb * 64 + tok; const size_t row = (size_t)b * SEQ + pos;
            float a[3][2];
#pragma unroll
            for (int t3 = 0; t3 < 3; ++t3) {
#pragma unroll
                for (int tap = 0; tap < 4; ++tap) { xw[t3][tap][0] = xw[t3][tap + 1][0]; xw[t3][tap][1] = xw[t3][tap + 1][1]; }
                const unsigned xv = xrow[t3][tt + 4]; xw[t3][4][0] = bflo(xv); xw[t3][4][1] = bfhi(xv);
                float a0 = 0.f, a1 = 0.f;
#pragma unroll
                for (int tap = 0; tap < 5; ++tap) { a0 += xw[t3][tap][0] * w[t3][tap][0]; a1 += xw[t3][tap][1] * w[t3][tap][1]; }
                a[t3][0] = siluf_(a0); a[t3][1] = siluf_(a1); }
            const float sq = wave_sum(a[0][0] * a[0][0] + a[0][1] * a[0][1]), sk = wave_sum(a[1][0] * a[1][0] + a[1][1] * a[1][1]);
            const float rq = __builtin_amdgcn_rsqf(sq + EPS) * 0.08838834764831845f, rk = __builtin_amdgcn_rsqf(sk + EPS);
            const size_t oo = row * 512 + h * 128 + 2 * lane;
            *(unsigned*)(GQ + oo) = cvt_pk_bf16(a[0][0] * rq, a[0][1] * rq); *(unsigned*)(GK + oo) = cvt_pk_bf16(a[1][0] * rk, a[1][1] * rk); *(unsigned*)(GV + oo) = cvt_pk_bf16(a[2][0], a[2][1]);
            const unsigned qv = qrow[tt], kv = krow[tt];
            const float q0 = bflo(qv), q1 = bfhi(qv), k0 = bflo(kv), k1 = bfhi(kv);
            const float rqa = __builtin_amdgcn_rsqf(half_sum(q0 * q0 + q1 * q1, lane) * (1.f / 64) + EPS) * qgs, rka = __builtin_amdgcn_rsqf(half_sum(k0 * k0 + k1 * k1, lane) * (1.f / 64) + EPS);
            const size_t oa = (((size_t)(b * 4 + h) * 2 + (lane >> 5)) * SEQ + pos) * 64 + 2 * (lane & 31);
            *(unsigned*)(AQ + oa) = cvt_pk_bf16(q0 * rqa * qg2[0], q1 * rqa * qg2[1]); *(unsigned*)(AK + oa) = cvt_pk_bf16(k0 * rka * kg2[0], k1 * rka * kg2[1]); }
    }
    if (tid < 128) { const size_t grow = (size_t)b * SEQ + tb * 64 + (tid >> 1); const int dir = tid & 1;
        const float sp = gav > 20.f ? gav : fast_log(1.f + fast_exp(gav));
        GG[grow * 8 + dir * 4 + h] = -fast_exp(alog[dir * 4 + h]) * sp; GBT[grow * 8 + dir * 4 + h] = sigmoidf_(gbv); }
    {
        const int l15_ = lane & 15, g_ = lane >> 4, q_ = l15_ >> 2, p_ = l15_ & 3, dv = 16 * wave + l15_, t0 = 16 * g_;
        const LAS unsigned char* tp = lds + 90304 + (t0 + q_) * 272 + (16 * wave + 4 * p_) * 2;
        const u32x2 c0 = lds_tr16(tp), c1 = lds_tr16(tp + 4 * 272), c2 = lds_tr16(tp + 8 * 272), c3 = lds_tr16(tp + 12 * 272);
        const u32x4 o0 = (u32x4){c0.x, c0.y, c2.x, c2.y}, o1 = (u32x4){c1.x, c1.y, c3.x, c3.y};
        bf16* d = AVT + ((size_t)(b * 4 + h) * 128 + dv) * SEQ + tb * 64 + t0; *(u32x4*)d = o0; *(u32x4*)(d + 8) = o1; }
    lds_barrier();
}

__device__ __forceinline__ int t5_bucket_dev(int rel) { const int n = rel < 0 ? -rel : rel; int lg;
    if (n < 8) lg = n; else if (n < 12) lg = 8; else if (n < 16) lg = 9; else if (n < 23) lg = 10; else if (n < 32) lg = 11; else if (n < 46) lg = 12; else if (n < 64) lg = 13; else if (n < 91) lg = 14; else lg = 15;
    return (rel > 0 ? 16 : 0) + lg; }
__device__ __forceinline__ f32x16 mfma32(bf16x8 a, bf16x8 b, f32x16 c) { return __builtin_amdgcn_mfma_f32_32x32x16_bf16(a, b, c, 0, 0, 0); }
__device__ __forceinline__ float wave_max(float v) {
    v = fmaxf(v, __int_as_float(__builtin_amdgcn_update_dpp(0, __float_as_int(v), 0xB1, 0xf, 0xf, true)));
    v = fmaxf(v, __int_as_float(__builtin_amdgcn_update_dpp(0, __float_as_int(v), 0x4E, 0xf, 0xf, true)));
    v = fmaxf(v, __int_as_float(__builtin_amdgcn_update_dpp(0, __float_as_int(v), 0x141, 0xf, 0xf, true)));
    v = fmaxf(v, __int_as_float(__builtin_amdgcn_update_dpp(0, __float_as_int(v), 0x140, 0xf, 0xf, true)));
    const int vi = __float_as_int(v);
    return fmaxf(fmaxf(__int_as_float(__builtin_amdgcn_readlane(vi, 0)), __int_as_float(__builtin_amdgcn_readlane(vi, 16))), fmaxf(__int_as_float(__builtin_amdgcn_readlane(vi, 32)), __int_as_float(__builtin_amdgcn_readlane(vi, 48))));
}
constexpr int AT_K = 2112 + 1984  , KSLOT = 64 * 128, AT_V = AT_K + 2 * KSLOT, VSLOT = 128 * 128, AT_Q = AT_V + 3 * VSLOT;
#ifndef ALT_GRP
#define ALT_GRP 1
#endif
template <int GRP, int VAR>
__device__ __forceinline__ void attn_tiles(LAS unsigned char* lds, f32x16 (&oacc)[4], float& lsum, const bf16* Kbase, const bf16* Vbase, int tid, int l31, int hh, int q0, int qrow, float cL, float cR, float mfix, const LAS unsigned char* QL) {
    constexpr int NT = SEQ / 64;
    const LAS float* BT = (const LAS float*)lds;
    const int lane = tid & 63, wv = __builtin_amdgcn_readfirstlane(tid >> 6);
    const int drow = lane >> 3, dpc = (lane & 7) ^ (((wv & 1) << 2) + (drow >> 1));
    const unsigned xs = (unsigned)(((l31 >> 1) & 7) << 4);
#define AT_DMA(kt_) do { const int t_ = (kt_); \
        __builtin_amdgcn_global_load_lds((const unsigned*)(Kbase + (size_t)(t_ * 64 + 8 * wv + drow) * 64 + dpc * 8), (LAS unsigned*)(lds + AT_K + (t_ & 1) * KSLOT + wv * 1024), 16, 0, 0); \
        _Pragma("unroll") for (int i_ = 0; i_ < 2; ++i_) \
            __builtin_amdgcn_global_load_lds((const unsigned*)(Vbase + (size_t)(8 * (wv + 8 * i_) + drow) * SEQ + t_ * 64 + dpc * 8), (LAS unsigned*)(lds + AT_V + (t_ % 3) * VSLOT + (wv + 8 * i_) * 1024), 16, 0, 0); } while (0)
    AT_DMA(0);
    unsigned pfw[16];
#pragma unroll
    for (int i = 0; i < 16; ++i) pfw[i] = 0u;
    f32x2 ps2 = (f32x2){0.f, 0.f};
    for (int kt = 0; kt < NT; ++kt) {
        const LAS unsigned char* KL = lds + AT_K + (kt & 1) * KSLOT; const LAS unsigned char* VP = lds + AT_V + ((kt + 2) % 3) * VSLOT;
        __syncthreads();
        if (kt + 1 < NT) AT_DMA(kt + 1);
        const int k0 = kt * 64;
        const bool farL = (k0 + 63 - q0 <= -128), farR = (k0 - (q0 + 31) >= 128);
        const float cinit = farL ? cL : (farR ? cR : -mfix);
        f32x16 sa[2];
#pragma unroll
        for (int sb = 0; sb < 2; ++sb)
#pragma unroll
            for (int r = 0; r < 16; ++r) sa[sb][r] = cinit;
        {   bf16x8 qq[4], ka[4][2];
#pragma unroll
            for (int ks = 0; ks < 4; ++ks) { qq[ks] = *(const LAS bf16x8*)(QL + 32 * ks);
#pragma unroll
                for (int sb = 0; sb < 2; ++sb) ka[ks][sb] = *(const LAS bf16x8*)(KL + (32 * sb + l31) * 128 + (((2 * ks + hh) << 4) ^ xs)); }
#pragma unroll
            for (int ks = 0; ks < 4; ++ks)
#pragma unroll
                for (int sb = 0; sb < 2; ++sb) sa[sb] = mfma32(ka[ks][sb], qq[ks], sa[sb]); }
        if (!(farL || farR)) { const LAS float* bp = BT + (k0 - qrow + 256 + 4 * hh);
#pragma unroll
            for (int sb = 0; sb < 2; ++sb)
#pragma unroll
                for (int r = 0; r < 16; ++r) sa[sb][r] += bp[32 * sb + (r & 3) + 8 * (r >> 2)]; }
        __builtin_amdgcn_sched_barrier(0);
        bf16x8 vf[8];
#pragma unroll
        for (int i = 0; i < 4; ++i) vf[i] = *(const LAS bf16x8*)(VP + (32 * i + l31) * 128 + (((0 + hh) << 4) ^ xs));
        unsigned pnw[16];
#pragma unroll
        for (int idx = 0; idx < 16; ++idx) { const int st = idx >> 2, d = idx & 3;
            if (idx + 4 < 16) { const int i2 = idx + 4, st2 = i2 >> 2, d2 = i2 & 3; vf[i2 & 7] = *(const LAS bf16x8*)(VP + (32 * d2 + l31) * 128 + (((2 * st2 + hh) << 4) ^ xs)); }
            const bf16x8 pb = __builtin_bit_cast(bf16x8, (u32x4){pfw[4 * st], pfw[4 * st + 1], pfw[4 * st + 2], pfw[4 * st + 3]});
            oacc[d] = mfma32(vf[idx & 7], pb, oacc[d]);
            asm volatile("" : "+v"(oacc[d]));
            {   const int sb = idx >> 3, r = 2 * (idx & 7); float s0 = sa[sb][r], s1 = sa[sb][r + 1];
                asm volatile("" : "+v"(s0), "+v"(s1));
                const float p0 = __builtin_amdgcn_exp2f(s0), p1 = __builtin_amdgcn_exp2f(s1); ps2 += (f32x2){p0, p1}; unsigned w = cvt_pk_bf16(p0, p1);
                asm volatile("" : "+v"(w), "+v"(ps2));
                pnw[idx] = w; }
            __builtin_amdgcn_sched_barrier(0);
        }
#pragma unroll
        for (int i = 0; i < 16; ++i) pfw[i] = pnw[i];
    }
    lsum += ps2[0] + ps2[1];
    {   const LAS unsigned char* VP = lds + AT_V + ((NT - 1) % 3) * VSLOT;
#pragma unroll
        for (int st = 0; st < 4; ++st) { const bf16x8 pb = __builtin_bit_cast(bf16x8, (u32x4){pfw[4 * st], pfw[4 * st + 1], pfw[4 * st + 2], pfw[4 * st + 3]});
#pragma unroll
            for (int d = 0; d < 4; ++d) oacc[d] = mfma32(*(const LAS bf16x8*)(VP + (32 * d + l31) * 128 + (((2 * st + hh) << 4) ^ xs)), pb, oacc[d]); } }
#undef AT_DMA
}
template <int VAR>
__device__ __forceinline__ void attn_unit(LAS unsigned char* lds, int unit, int tid, const bf16* AQ, const bf16* AK, const bf16* AVT, const float* relb, const float* qg, const float* kg, bf16* AO) {
    const int qb = unit & 31, bhc = unit >> 5, bh = bhc >> 1, h = bh & 3, lane = tid & 63, wave = tid >> 6, l31 = lane & 31, hh = lane >> 5;
    LAS float* BT = (LAS float*)lds;
    const int q0 = qb * 256 + wave * 32, qrow = q0 + l31;
    int rel = tid - 256; rel = rel < -128 ? -128 : (rel > 128 ? 128 : rel);
    const float btv = relb[t5_bucket_dev(rel) * 4 + h], qgv = qg[lane], kgv = kg[lane], rbv = lane < 32 ? relb[lane * 4 + h] : 0.f, cLv = relb[15 * 4 + h], cRv = relb[31 * 4 + h];
    bf16x8 qv[4];
#pragma unroll
    for (int ks = 0; ks < 4; ++ks) qv[ks] = *(const bf16x8*)(AQ + ((size_t)bhc * SEQ + qrow) * 64 + 16 * ks + 8 * hh);
    BT[tid] = btv * LOG2E;
    for (int i = tid; i < VSLOT / 4; i += 512) ((LAS unsigned*)(lds + AT_V + 2 * VSLOT))[i] = 0u;
    const float gqm = wave_max(fabsf(qgv)), gkm = wave_max(fabsf(kgv)), bmx = wave_max(fabsf(rbv));
    const float mfix = 8.f * LOG2E * gqm * gkm * 1.03f + bmx * LOG2E;
    LAS unsigned char* QL = lds + AT_Q + (wave * 32 + l31) * 144 + 16 * hh;
#pragma unroll
    for (int ks = 0; ks < 4; ++ks) *(LAS bf16x8*)(QL + 32 * ks) = qv[ks];
    f32x16 oacc[4];
#pragma unroll
    for (int d = 0; d < 4; ++d)
#pragma unroll
        for (int r = 0; r < 16; ++r) oacc[d][r] = 0.f;
    float lsum = 0.f;
    const bf16* Kbase = AK + (size_t)bhc * SEQ * 64; const bf16* Vbase = AVT + (size_t)bh * 128 * SEQ;
    const float cL = cLv * LOG2E - mfix, cR = cRv * LOG2E - mfix;
    if (wave < 4) attn_tiles<0, VAR>(lds, oacc, lsum, Kbase, Vbase, tid, l31, hh, q0, qrow, cL, cR, mfix, QL);
    else attn_tiles<1, VAR>(lds, oacc, lsum, Kbase, Vbase, tid, l31, hh, q0, qrow, cL, cR, mfix, QL);
    const float ltot = lsum + shfl_xor32(lsum, lane), inv = 1.f / ltot;
    bf16* orow = AO + ((size_t)bhc * SEQ + qrow) * 128;
#pragma unroll
    for (int d = 0; d < 4; ++d)
#pragma unroll
        for (int g4 = 0; g4 < 4; ++g4) { u32x2 w; w.x = cvt_pk_bf16(oacc[d][4 * g4] * inv, oacc[d][4 * g4 + 1] * inv); w.y = cvt_pk_bf16(oacc[d][4 * g4 + 2] * inv, oacc[d][4 * g4 + 3] * inv); *(u32x2*)(orow + 32 * d + 8 * g4 + 4 * hh) = w; }
    __syncthreads();
}

__device__ __forceinline__ void acomb_phase(const bf16* AO, const float* clam  , const float* outg  , float lam_init, bf16* MIX, int gw, int NGW, int lane) {
    const float s01 = wave_sum(clam[lane] * clam[64 + lane]), s23 = wave_sum(clam[128 + lane] * clam[192 + lane]);
    const float lam_full = expf(s01) - expf(s23) + lam_init;
    const float g0 = outg[2 * lane] * (1.f - lam_init), g1 = outg[2 * lane + 1] * (1.f - lam_init);
#pragma unroll 2
    for (int row = gw; row < T; row += NGW) { const int b = row >> 13, pos = row & (SEQ - 1);
        unsigned o0[4], o1[4];
#pragma unroll
        for (int h = 0; h < 4; ++h) { o0[h] = *(const unsigned*)(AO + (((size_t)(b * 4 + h) * 2 + 0) * SEQ + pos) * 128 + 2 * lane); o1[h] = *(const unsigned*)(AO + (((size_t)(b * 4 + h) * 2 + 1) * SEQ + pos) * 128 + 2 * lane); }
#pragma unroll
        for (int h = 0; h < 4; ++h) { const float a0 = bflo(o0[h]) - lam_full * bflo(o1[h]), a1 = bfhi(o0[h]) - lam_full * bfhi(o1[h]);
            const float rs = __builtin_amdgcn_rsqf(wave_sum(a0 * a0 + a1 * a1) * (1.f / 128) + EPS);
            *(unsigned*)(MIX + (size_t)row * DM + h * 128 + 2 * lane) = cvt_pk_bf16(QM(a0 * rs * g0), QM(a1 * rs * g1)); } }
}
__device__ __forceinline__ void scomb_phase(const bf16* OS, const float* outg, const bf16* gate, int gstride, int goff, bool gate_silu, bf16* MIX, int coff, int gw, int NGW, int lane) {
    const float g0 = outg[2 * lane], g1 = outg[2 * lane + 1];
#pragma unroll 2
    for (int row = gw; row < T; row += NGW) { const int b = row >> 13, pos = row & (SEQ - 1);
        unsigned of[4], ob[4]; unsigned gv[4];
#pragma unroll
        for (int h = 0; h < 4; ++h) { of[h] = *(const unsigned*)(OS + ((size_t)b * SEQ + pos) * 512 + h * 128 + 2 * lane); ob[h] = *(const unsigned*)(OS + ((size_t)T + (size_t)b * SEQ + (SEQ - 1 - pos)) * 512 + h * 128 + 2 * lane);
            gv[h] = *(const unsigned*)(gate + (size_t)row * gstride + goff + h * 128 + 2 * lane); }
#pragma unroll
        for (int h = 0; h < 4; ++h) { const float a0 = bflo(of[h]) + bflo(ob[h]), a1 = bfhi(of[h]) + bfhi(ob[h]);
            const float rs = __builtin_amdgcn_rsqf(wave_sum(a0 * a0 + a1 * a1) * (1.f / 128) + EPS);
            float t0 = bflo(gv[h]), t1 = bfhi(gv[h]);
            if (gate_silu) { t0 = siluf_(t0); t1 = siluf_(t1); }
            *(unsigned*)(MIX + (size_t)row * DM + coff + h * 128 + 2 * lane) = cvt_pk_bf16(QM(a0 * rs * g0 * t0), QM(a1 * rs * g1 * t1)); } }
}
#ifndef REP_ATTN
#define REP_ATTN 1
#endif
#ifndef REP_SCAN
#define REP_SCAN 1
#endif
#ifndef REP_SCANO
#define REP_SCANO REP_SCAN
#endif
#ifndef NCONV_FIRST
#define NCONV_FIRST 32
#endif
#ifndef REP_CONV
#define REP_CONV 1
#endif
#ifndef REP_PRE
#define REP_PRE 1
#endif
#ifndef REP_MISC
#define REP_MISC 1
#endif
#ifndef REP_MOEG
#define REP_MOEG 1
#endif
#ifndef REP_NORM
#define REP_NORM 1
#endif
#ifndef REP_X1
#define REP_X1 1
#endif
#ifndef REP_X2
#define REP_X2 1
#endif
#ifndef DUP_GEMM
#define DUP_GEMM 0
#endif
#ifdef EMU2
#define QS_IN ((EMU2 & 2) ? 64.f : 0.f)
#define QS_OUT ((EMU2 & 1) ? 64.f : 0.f)
#else
#define QS_IN 0.f
#define QS_OUT 0.f
#endif
#ifndef PHMASK
#define PHMASK 0xffffffffu
#endif
#define PH(n) ((PHMASK >> (n)) & 1u)
#define WEI ((bf16*)(ws + WS_WEI))
#define WOI ((bf16*)(ws + WS_WOI))
#define WEO ((bf16*)(ws + WS_WEO))
#define WOO ((bf16*)(ws + WS_WOO))
#define WGL ((bf16*)(ws + WS_WGL))
#define LBT ((float*)(ws + WS_LB))
#define KTAB ((float*)(ws + WS_KTAB))
#define TW ((bf16*)(ws + WS_TW))
#define SV ((bf16*)(ws + WS_SV))
#define WGU ((bf16*)(ws + WS_WGU))
#define WD ((bf16*)(ws + WS_WD))
#define HN ((bf16*)(ws + WS_HN))
#define MIX ((bf16*)(ws + WS_MIX))
#define QD ((bf16*)(ws + WS_R + R_QD))
#define KDT ((bf16*)(ws + WS_R + R_KDT))
#define VAL ((bf16*)(ws + WS_R + R_VAL))
#define KC ((bf16*)(ws + WS_R + R_KC))
#define AT ((bf16*)(ws + WS_R + R_AT))
#define DEC ((float*)(ws + WS_R + R_DEC))
#define OS ((bf16*)(ws + WS_R + R_OS))
#define QS ((bf16*)(ws + WS_R + R_QS))
#define ZF ((bf16*)(ws + WS_R + R_ZF))
#define ZB ((bf16*)(ws + WS_R + R_ZB))
#define VI ((bf16*)(ws + WS_R + R_VI))
#define GA ((bf16*)(ws + WS_R + R_GA))
#define UP ((bf16*)(ws + WS_R + R_UP))
#define EB ((float*)(ws + WS_R + R_EB))
#define YG ((bf16*)(ws + WS_R + R_YG))
#define PO ((bf16*)(ws + WS_R + R_PO))
#define AB ((float*)(ws + WS_R + R_AB))
#define AQ ((bf16*)(ws + WS_R + R_AQ))
#define AK ((bf16*)(ws + WS_R + R_AK))
#define AVT ((bf16*)(ws + WS_R + R_AVT))
#define AO ((bf16*)(ws + WS_R + R_AO))
#define GQ ((bf16*)(ws + WS_R + R_GQ))
#define GK ((bf16*)(ws + WS_R + R_GK))
#define GV ((bf16*)(ws + WS_R + R_GV))
#define GG ((float*)(ws + WS_R + R_GG))
#define GBT ((float*)(ws + WS_R + R_GB))
#define AFF ((float*)(ws + WS_R + R_AFF))
#define SEL ((int*)(ws + WS_R + R_SEL))
#define IDX ((int*)(ws + WS_R + R_IDX))
#define GATE ((float*)(ws + WS_R + R_GATE))
#define XG ((bf16*)(ws + WS_R + R_XG))
#define HN8 ((bf16*)(ws + WS_R + R_XG))
#define HID ((bf16*)(ws + WS_R + R_HID))
#define YS ((bf16*)(ws + WS_R + R_YS))
#define YS8 ((unsigned char*)(ws + WS_R + R_YS))
#define KIN(i) ((const float*)(const GAS float*)kp[i])
#define X ((float*)(GAS float*)kp[32])
#define XB ((bf16*)(ws + WS_XB))

__global__ void __launch_bounds__(512, 2) hybrid_fwd(Args A) {
    extern __shared__ __attribute__((aligned(16))) unsigned char lds_raw[];
    LAS unsigned char* lds = (LAS unsigned char*)lds_raw;
    const int G0 = gridDim.x, bx0 = blockIdx.x;
    typedef const float* const __attribute__((address_space(4))) * KArgP;
    KArgP kp0 = (KArgP)__builtin_amdgcn_kernarg_segment_ptr();
    unsigned char* ws0 = (unsigned char*)kp0[33];
    int tid, lane, wave, gw, G, bx, NGW; GAS unsigned char* wsg; KArgP kp;
#define ws ((unsigned char*)wsg)
#define RELAUNDER() do { G = G0; asm volatile("" : "+s"(G)); bx = bx0; asm volatile("" : "+s"(bx)); NGW = G * 8; tid = threadIdx.x; asm volatile("" : "+v"(tid)); wsg = (GAS unsigned char*)ws0; asm volatile("" : "+s"(wsg)); kp = kp0; asm volatile("" : "+s"(kp)); lane = tid & 63; wave = __builtin_amdgcn_readfirstlane(tid >> 6); gw = bx * 8 + wave; } while (0)
    const int tid0 = threadIdx.x;
    volatile LAS unsigned* MISC = (volatile LAS unsigned*)(lds + MISC_OFF);
    for (int u = tid0; u < (LDS_BYTES - RING_BYTES) / 4; u += 512) ((LAS unsigned*)(lds + RING_BYTES))[u] = 0u;
    __syncthreads();
    XcdBarrier bar = xcd_barrier_post((unsigned*)(ws0 + WS_CTL), MISC + 8);
#define GRID_BAR() do { xcd_barrier_t<false>(bar); RELAUNDER(); } while (0)
#define GRID_BAR_FIRST() do { xcd_barrier_t<true>(bar); RELAUNDER(); } while (0)
    RELAUNDER();
    if (PH(23)) {
        LAS float* scr = (LAS float*)(lds + wave * 16384);
        constexpr int IE = 16 * 96, IO = 16 * 112, IP = 16 * 32, IG = 8 * 16;
        constexpr int NIT = 2 * (IE + IO + IP + IP + IG);
        for (int it = gw; it < NIT; it += NGW) { int r = it; const int j = r & 1; r >>= 1;
            if (r < IE) { tr_item(KIN(I_EVWIN) + (size_t)j * DM * EVEN_IN, EVEN_IN, WEI + (size_t)j * EVEN_IN * DM, DM, (r / 96) * 64, (r % 96) * 32, (r % 96) * 32, scr, lane, QS_IN); continue; } r -= IE;
            if (r < IO) { const int nd = (r % 112) * 32, nsrc = nd < 3072 ? nd : nd + 16; tr_item(KIN(I_ODWIN) + (size_t)j * DM * ODD_IN, ODD_IN, WOI + (size_t)j * ODD_N * DM, DM, (r / 112) * 64, nsrc, nd, scr, lane, QS_IN); continue; } r -= IO;
            if (r < IP) { tr_item(KIN(I_EVWOUT) + (size_t)j * DM * DM, DM, WEO + (size_t)j * DM * DM, DM, (r / 32) * 64, (r % 32) * 32, (r % 32) * 32, scr, lane, QS_OUT); continue; } r -= IP;
            if (r < IP) { tr_item(KIN(I_ODWOUT) + (size_t)j * DM * DM, DM, WOO + (size_t)j * DM * DM, DM, (r / 32) * 64, (r % 32) * 32, (r % 32) * 32, scr, lane, QS_OUT); continue; } r -= IP;
            tr_item(KIN(I_S5GW) + (size_t)j * 512 * 512, 512, WGL + (size_t)j * 512 * 512, 512, (r / 16) * 64, (r % 16) * 32, (r % 16) * 32, scr, lane); }
        if (bx == 0) { for (int i = tid; i < 1024; i += 512) { const float l0 = KIN(I_ALB)[i], l1 = KIN(I_ALB)[1024 + i]; const float m = fmaxf(l0, l1), e0 = expf(l0 - m), e1 = expf(l1 - m);
                LBT[i] = 0.f; LBT[1024 + i] = e1 / (e0 + e1); } }
        LAS float* kscr = scr;
        {   Args AL; for (int i_ = I_S5LRE; i_ <= I_S5D; ++i_) AL.in[i_] = KIN(i_);
            for (int it = gw; it < 2 * 2 * 32 * 64; it += NGW) s5_ktab_item(AL, KTAB, it, kscr, lane); }
    }
    GRID_BAR_FIRST();
    for (int rep_ = 0; rep_ < REP_X2; ++rep_) if (PH(24)) { Args AL; for (int i_ = I_S5LRE; i_ <= I_S5D; ++i_) AL.in[i_] = KIN(i_); for (int u = bx; u < 4096; u += G) s5_tw_unit(AL, KTAB, TW, u, tid, (LAS float*)lds); }
    for (int rep_ = 0; rep_ < REP_X2; ++rep_) if (PH(24)) { Args AL; for (int i_ = I_S5LRE; i_ <= I_S5D; ++i_) AL.in[i_] = KIN(i_); for (int u = bx; u < 256; u += G) s5_sv_unit(AL, SV, u, tid); }

    for (int layer = 0; layer < 4; ++layer) {
        const int j = layer >> 1; const bool even = (layer & 1) == 0;
        if (layer == 0) { norm_phase(lds, KIN(I_X), KIN(I_MIXN), HN, 0, nullptr, 0, nullptr, bx, G, tid); GRID_BAR(); }
        if (even) {
            if (PH(1)) {   pg8::Gemm g{HN, WEI + (size_t)j * EVEN_IN * DM, DM, DM, DM}; pg8::Sched S; S.init(128, 12, G, bx, 20, 0);
                EpiEvenIn E{QS, ZF, ZB, VI, GA, UP}; pg8::gemm_phase(lds, g, S, E, tid); }
#if (DUP_GEMM >> 0) & 1
            __syncthreads();
            if (PH(1)) {   pg8::Gemm g{HN, WEI + (size_t)j * EVEN_IN * DM, DM, DM, DM}; pg8::Sched S; S.init(128, 12, G, bx, 20, 0);
                EpiEvenIn E{QS, ZF, ZB, VI, GA, UP}; pg8::gemm_phase(lds, g, S, E, tid); }
#endif
            GRID_BAR();
            if (PH(3)) {   pg8::Gemm g{UP, SV + (size_t)j * 32 * 256 * 1024, 1024, 1280, 1024}; pg8::Sched S; S.init(64, 1, G, bx, 1, 1);
                EpiF32 E{EB, 256}; pg8::gemm_phase(lds, g, S, E, tid); }
            __syncthreads();
            if (PH(2)) hpre_phase(lds, (unsigned*)(ws + WS_CTL) + CW_Q + 64 * (12 + layer), MISC + 16, tid, LBT + j * 1024, QS, ZF, ZB, QD, KDT, AT, DEC);
#ifdef REP_HPRE
            if (PH(2)) hpre_phase(lds, (unsigned*)(ws + WS_CTL) + CW_Q + 64 * (16 + layer), MISC + 16, tid, LBT + j * 1024, QS, ZF, ZB, QD, KDT, AT, DEC);
#endif
#if (DUP_GEMM >> 1) & 1
            __syncthreads();
            if (PH(3)) {   pg8::Gemm g{UP, SV + (size_t)j * 32 * 256 * 1024, 1024, 1280, 1024}; pg8::Sched S; S.init(64, 1, G, bx, 1, 1);
                EpiF32 E{EB, 256}; pg8::gemm_phase(lds, g, S, E, tid); }
#endif
            GRID_BAR();
            if (!PH(4)) {} else if (bx < 64) { for (int rep_ = 0; rep_ < REP_SCAN; ++rep_) scan_unit<false>(lds, (bx & 7) * 8 + (bx >> 3), tid, QD, KDT, VI, KC, AT, DEC, OS); }
            else if (bx >= 128 && bx < 160) { Args AL; for (int i_ = I_S5LRE; i_ <= I_S5LS; ++i_) AL.in[i_] = KIN(i_); s5_carry(AL, j, EB, UP, (bx - 128) * 512 + tid); }
            __syncthreads();
            if (PH(17)) moe_convert_phase(lds, KIN(I_WGATE) + (size_t)layer * NE * DM * FF, KIN(I_WUP) + (size_t)layer * NE * DM * FF, KIN(I_WDOWN) + (size_t)layer * NE * FF * DM, WGU, WD, (unsigned*)(ws + WS_CTL) + CW_Q + 64 * (2 * layer), MISC + 16, tid, wave, lane);
            GRID_BAR();
            for (int rep_ = 0; rep_ < REP_X1; ++rep_) if (PH(5)) scomb_phase(OS, KIN(I_AOUTN) + j * 128, GA, 512, 0, false, MIX, 0, gw, NGW, lane);
            if (PH(6)) {   pg8::Gemm g{UP, TW + (size_t)j * 32 * 1024 * 1280, 1280, 1280, 1280}; pg8::Sched S; S.init(64, 4, G, bx, 1, 4);
                EpiS5Main E{YG}; pg8::gemm_phase(lds, g, S, E, tid); }
#if (DUP_GEMM >> 2) & 1
            __syncthreads();
            if (PH(6)) {   pg8::Gemm g{UP, TW + (size_t)j * 32 * 1024 * 1280, 1280, 1280, 1280}; pg8::Sched S; S.init(64, 4, G, bx, 1, 4);
                EpiS5Main E{YG}; pg8::gemm_phase(lds, g, S, E, tid); }
#endif
            GRID_BAR();
            if (PH(7)) {   pg8::Gemm g{YG, WGL + (size_t)j * 512 * 512, 512, 512, 512}; pg8::Sched S; S.init(128, 2, G, bx, 20, 0);
                EpiGlu E{YG, KIN(I_S5GB) + j * 512, MIX}; pg8::gemm_phase(lds, g, S, E, tid); }
#if (DUP_GEMM >> 3) & 1
            __syncthreads();
            if (PH(7)) {   pg8::Gemm g{YG, WGL + (size_t)j * 512 * 512, 512, 512, 512}; pg8::Sched S; S.init(128, 2, G, bx, 20, 0);
                EpiGlu E{YG, KIN(I_S5GB) + j * 512, MIX}; pg8::gemm_phase(lds, g, S, E, tid); }
#endif
            GRID_BAR();
        } else {
            if (PH(8)) {   pg8::Gemm g{HN, WOI + (size_t)j * ODD_N * DM, DM, DM, DM}; pg8::Sched S; S.init(128, 14, G, bx, 20, 0);
                EpiBf16 E{PO, ODD_N}; pg8::gemm_phase(lds, g, S, E, tid); }
#if (DUP_GEMM >> 4) & 1
            __syncthreads();
            if (PH(8)) {   pg8::Gemm g{HN, WOI + (size_t)j * ODD_N * DM, DM, DM, DM}; pg8::Sched S; S.init(128, 14, G, bx, 20, 0);
                EpiBf16 E{PO, ODD_N}; pg8::gemm_phase(lds, g, S, E, tid); }
#endif
            GRID_BAR();
            for (int rep_ = 0; rep_ < REP_MISC; ++rep_) if (PH(9)) for (int u = bx; u < 2048; u += G) oprep_unit(lds, u, tid, PO, AB, KIN(I_DCONV) + (size_t)j * 5 * 1536, KIN(I_DALOG) + j * 8, KIN(I_DDTB) + j * 8, KIN(I_CQN) + j * 64, KIN(I_CKN) + j * 64, AQ, AK, AVT, GQ, GK, GV, GG, GBT);
            GRID_BAR();
            if (PH(11)) gpre_phase<0>(lds, bx, G, tid, GQ, GK, GV, GG, GBT, QD, KDT, VAL, KC, AT, DEC);
#ifdef GPRE_VAR
            gpre_phase<GPRE_VAR>(lds, bx, G, tid, GQ, GK, GV, GG, GBT, QD, KDT, VAL, KC, AT, DEC);
#endif
            GRID_BAR();
            if (PH(12)) if (bx < 64) { for (int rep_ = 0; rep_ < REP_SCANO; ++rep_) scan_unit<true>(lds, (bx & 7) * 8 + (bx >> 3), tid, QD, KDT, VAL, KC, AT, DEC, OS); }
            if (PH(13)) for (;;) { const int u = wq_next_xcd((unsigned*)(ws + WS_CTL) + CW_Q + 64 * (24 + 8 * layer), (int)(xb_xcc_id() & 7u), 128, MISC + 16, tid); if (u < 0) break; attn_unit<0>(lds, u, tid, AQ, AK, AVT, KIN(I_RELB), KIN(I_CQN) + j * 64, KIN(I_CKN) + j * 64, AO); }
#if defined(REP_ATTN2)
            if (PH(13)) for (;;) { const int u = wq_next((unsigned*)(ws + WS_CTL) + CW_Q + 64 * (8 + layer), MISC + 16, tid); if (u >= 1024) break; attn_unit<REP_ATTN2>(lds, u, tid, AQ, AK, AVT, KIN(I_RELB), KIN(I_CQN) + j * 64, KIN(I_CKN) + j * 64, (bf16*)(ws + WS_END)); }
#endif
            if (PH(17)) moe_convert_phase(lds, KIN(I_WGATE) + (size_t)layer * NE * DM * FF, KIN(I_WUP) + (size_t)layer * NE * DM * FF, KIN(I_WDOWN) + (size_t)layer * NE * FF * DM, WGU, WD, (unsigned*)(ws + WS_CTL) + CW_Q + 64 * (2 * layer), MISC + 16, tid, wave, lane);
            GRID_BAR();
            for (int rep_ = 0; rep_ < REP_X1; ++rep_) if (PH(14)) acomb_phase(AO, KIN(I_CLAM) + j * 256, KIN(I_COUTN) + j * 128, 0.8f - 0.6f * expf(-0.3f * (float)layer), MIX, gw, NGW, lane);
            for (int rep_ = 0; rep_ < REP_X1; ++rep_) if (PH(14)) scomb_phase(OS, KIN(I_DOUTN) + j * 128, PO, ODD_N, 3072, true, MIX, 512, gw, NGW, lane);
            GRID_BAR();
        }
        if (PH(15)) {   pg8::Gemm g{MIX, (even ? WEO : WOO) + (size_t)j * DM * DM, DM, DM, DM}; pg8::Sched S; S.init(128, 4, G, bx, 20, 0);
            EpiResid E{layer == 0 ? KIN(I_X) : (const float*)nullptr, XB}; pg8::gemm_phase(lds, g, S, E, tid); }
        GRID_BAR();
        for (int rep_ = 0; rep_ < REP_NORM; ++rep_) if (PH(16)) norm_phase(lds, (const bf16*)XB, KIN(I_FFNN) + layer * DM, HN8, 1, KIN(I_ROUTER) + (size_t)layer * DM * NE, NE, AFF, bx, G, tid);
        GRID_BAR();
        for (int rep_ = 0; rep_ < REP_MISC; ++rep_) if (PH(18)) for (int u = bx; u < NB * NE; u += G) topk_unit(lds, AFF, SEL, IDX, GATE, u, tid);
        GRID_BAR();
        if (PH(20)) {
            pg8::Gemm g{(const bf16*)HN8, WGU, DM / 2, DM / 2, DM / 2}; pg8::Sched S; S.init(256, 16, G, bx, 4, 16);
            LAS int* tab = (LAS int*)(lds + 131072);
#pragma nounroll
            for (int i0 = 0; i0 < 16; i0 += 8) { int iv[8]; bool okv[8];
#pragma unroll
                for (int k = 0; k < 8; ++k) { pg8::Unit u; okv[k] = S.next(i0 + k, u) && tid < 256; iv[k] = 0; if (okv[k]) { const int slot = u.pm * 256 + tid; iv[k] = ((slot >> 10) & 3) * SEQ + IDX[slot]; } }
#pragma unroll
                for (int k = 0; k < 8; ++k) if (okv[k]) tab[(i0 + k) * 256 + tid] = iv[k]; }
            __syncthreads();
            EpiMoe1 E{(unsigned char*)HID, 1.f / 512.f}; pg8::gemm_phase_g8(lds, g, S, E, tid, tab);
#ifdef REP_G1
            __syncthreads(); pg8::gemm_phase_g8(lds, g, S, E, tid, tab);
#endif
            }
#if REP_MOEG > 1
        __syncthreads();
        if (PH(20)) {   pg8::Gemm g{XG, WGU, DM, DM, DM}; pg8::Sched S; S.init(256, 16, G, bx, 4, 16);
            EpiMoe1 E{(unsigned char*)HID, 1.f}; pg8::gemm_phase(lds, g, S, E, tid); }
#endif
        GRID_BAR();
        if (PH(21)) {   pg8::Gemm g{HID, WD, FF / 2, FF / 2, FF / 2}; pg8::Sched S; S.init(256, 4, G, bx, 4, 4);
            EpiFp8S E{YS8, DM, 64.f / 256.f}; pg8::gemm_phase8(lds, g, S, E, tid);
#ifdef REP_G2
            __syncthreads(); pg8::gemm_phase8(lds, g, S, E, tid);
#endif
            }
#if REP_MOEG > 1
        __syncthreads();
        if (PH(21)) {   pg8::Gemm g{HID, WD, FF, FF, FF}; pg8::Sched S; S.init(256, 4, G, bx, 4, 4);
            EpiBf16 E{YS, DM}; pg8::gemm_phase(lds, g, S, E, tid); }
#endif
        GRID_BAR();
        {   const int nl = layer + 1; const int nmode = nl >= 4 ? -1 : ((nl & 1) ? 2 : 0);
            combine_phase(lds, XB, nl >= 4 ? X : (float*)nullptr, SEL, GATE, YS8, nmode, KIN(I_MIXN) + (nl & 3) * DM, HN, KIN(I_ODWIN) + (size_t)(nl >> 1 & 1) * DM * ODD_IN + 3072, ODD_IN, AB, gw, NGW, tid); }
        GRID_BAR();
    }
#ifdef XTRA_BARS
    for (int i_ = 0; i_ < XTRA_BARS; ++i_) GRID_BAR();
#endif
    if (__hip_atomic_load((unsigned*)(ws + WS_CTL) + XB_TMO, __ATOMIC_RELAXED, __HIP_MEMORY_SCOPE_AGENT) != 0u) {
        const float q = __builtin_nanf(""); for (size_t i = (size_t)bx * 512 + tid; i < (size_t)T * DM; i += (size_t)G * 512) X[i] = q; }
}

#undef ws
#undef X
#undef XB
extern "C" void kernel_launch(void* const* d_in, const int* in_sizes, int n_in, void* d_out, int out_size, void* d_ws, size_t ws_size, hipStream_t stream) {
    static int grid = 0;
    if (grid == 0) {
        if (n_in != 32 || out_size != T * DM || ws_size < WS_END) { fprintf(stderr, "kernel_launch: unexpected shapes (n_in %d, out %d, ws %zu < %zu)\n", n_in, out_size, ws_size, (size_t)WS_END); grid = -1; return; }
        int dev = 0, cus = 0, per_cu = 0;
        if (hipGetDevice(&dev) != hipSuccess || hipDeviceGetAttribute(&cus, hipDeviceAttributeMultiprocessorCount, dev) != hipSuccess) { grid = -1; return; }
        if (hipFuncSetAttribute((const void*)hybrid_fwd, hipFuncAttributeMaxDynamicSharedMemorySize, LDS_BYTES) != hipSuccess) { fprintf(stderr, "kernel_launch: hipFuncSetAttribute failed\n"); grid = -1; return; }
        if (hipOccupancyMaxActiveBlocksPerMultiprocessor(&per_cu, (const void*)hybrid_fwd, 512, LDS_BYTES) != hipSuccess || per_cu < 1) fprintf(stderr, "kernel_launch: occupancy query says %d\n", per_cu);
        (void)hipGetLastError();
        grid = cus;
        if (grid > 256) grid = 256;
    }
    if (grid < 0) return;
    if (hipMemsetAsync((char*)d_ws + WS_CTL, 0, CTL_BYTES, stream) != hipSuccess) return;
    Args a{};
    for (int i = 0; i < 32; ++i) a.in[i] = (const float*)d_in[i];
    a.out = (float*)d_out; a.ws = (unsigned char*)d_ws;
    hipLaunchKernelGGL(hybrid_fwd, dim3(grid), dim3(512), LDS_BYTES, stream, a);
    const hipError_t le = hipPeekAtLastError();
    if (le != hipSuccess) fprintf(stderr, "kernel_launch: launch failed: %s\n", hipGetErrorName(le));
}
```
